# Optimizing an MI355X kernel written in HIP

```python
import jax, jax.numpy as jnp
from jax import lax
import numpy as np

D_MODEL = 2048
BATCH = 1
SEQ = 8192
DEPTH = 4
DEC_BATCH = 16
DEC_SEQ = 16
PAST_LEN = 2048

CHUNK = 64
N_A_LAYERS = DEPTH // 2
N_B_LAYERS = DEPTH - N_A_LAYERS
D_FF = 5632
GMLP_CHUNK = 128
D_GATE = 2 * D_MODEL
GMLP_GROUPS = 4
N_HEADS = 16
HEAD_DIM = D_MODEL // N_HEADS
Q_BLOCK = 128
RMS_EPS = 1e-6
LN_EPS = 1e-5
NEG_INF = -1e30

kernel_name = 'yoco_gmlp_fox_macaron_stream_step'


def rmsnorm(x, g):
    xf = x.astype(jnp.float32)
    y = xf * lax.rsqrt(jnp.mean(xf * xf, axis=-1, keepdims=True) + RMS_EPS)
    return (y * g.astype(jnp.float32)).astype(x.dtype)


def layernorm(x, g, b):
    xf = x.astype(jnp.float32)
    mu = jnp.mean(xf, axis=-1, keepdims=True)
    xc = xf - mu
    y = xc * lax.rsqrt(jnp.mean(xc * xc, axis=-1, keepdims=True) + LN_EPS)
    return (y * g.astype(jnp.float32) + b.astype(jnp.float32)).astype(x.dtype)


def half_ffn(x, g, w_gate, w_up, w_down):
    h = rmsnorm(x, g)
    return x + 0.5 * ((jax.nn.silu(h @ w_gate) * (h @ w_up)) @ w_down)


def gmlp_mix(h, w_in, ln_g, ln_b, w_s, b_s, w_out):
    bsz, s, _ = h.shape
    L = min(s, GMLP_CHUNK)
    z = jax.nn.gelu(h @ w_in, approximate=False)
    u, v = jnp.split(z, 2, axis=-1)
    vn = layernorm(v, ln_g, ln_b)
    tril = jnp.tril(jnp.ones((L, L), dtype=bool))
    ws = jnp.where(tril[None], w_s[:, :L, :L], 0).astype(vn.dtype)
    v5 = vn.reshape(bsz, s // L, L, GMLP_GROUPS, D_GATE // GMLP_GROUPS)
    mixed = jnp.einsum('gts,bnsgc->bntgc', ws, v5) + b_s[:, :L].T[:, :, None]
    gated = u * mixed.reshape(bsz, s, D_GATE)
    return gated @ w_out, vn


def shared_kv(x, kv_norm, w_k, w_v, w_f, b_f):
    bsz, s, _ = x.shape
    h = rmsnorm(x, kv_norm)
    k = (h @ w_k).reshape(bsz, s, N_HEADS, HEAD_DIM)
    v = (h @ w_v).reshape(bsz, s, N_HEADS, HEAD_DIM)
    logf = jax.nn.log_sigmoid((h @ w_f).astype(jnp.float32) + b_f.astype(jnp.float32)).astype(x.dtype)
    return k, v, logf


def fox_prompt(q, k, v, logf):
    bsz, s = q.shape[:2]
    nb = s // Q_BLOCK
    c = jnp.cumsum(logf.astype(jnp.float32), axis=1)
    c_k = jnp.transpose(c, (0, 2, 1))[:, :, None, :]
    k_pos = jnp.arange(s)
    q_blk = jnp.moveaxis(q.reshape(bsz, nb, Q_BLOCK, N_HEADS, HEAD_DIM), 1, 0)
    cq_blk = jnp.moveaxis(c.reshape(bsz, nb, Q_BLOCK, N_HEADS), 1, 0)
    pos_blk = jnp.arange(s).reshape(nb, Q_BLOCK)
    scale = HEAD_DIM ** -0.5

    def block(args):
        qb, cqb, qpos = args
        logits = jnp.einsum('bqhd,bkhd->bhqk', qb, k, preferred_element_type=jnp.float32) * scale
        logits = logits + jnp.transpose(cqb, (0, 2, 1))[..., None] - c_k
        logits = jnp.where(qpos[:, None] >= k_pos[None, :], logits, NEG_INF)
        p = jax.nn.softmax(logits, axis=-1).astype(v.dtype)
        return jnp.einsum('bhqk,bkhd->bqhd', p, v)

    out = lax.map(block, (q_blk, cq_blk, pos_blk))
    return jnp.moveaxis(out, 0, 1).reshape(bsz, s, N_HEADS * HEAD_DIM)


def fox_sample(q, k_all, v_all, logf_all, past_len):
    bsz, t = q.shape[:2]
    n = k_all.shape[1]
    c = jnp.cumsum(logf_all.astype(jnp.float32), axis=1)
    cq = c[:, past_len:]
    scale = HEAD_DIM ** -0.5
    logits = jnp.einsum('bqhd,bkhd->bhqk', q, k_all, preferred_element_type=jnp.float32) * scale
    logits = logits + jnp.transpose(cq, (0, 2, 1))[..., None] - jnp.transpose(c, (0, 2, 1))[:, :, None, :]
    mask = (past_len + jnp.arange(t))[:, None] >= jnp.arange(n)[None, :]
    logits = jnp.where(mask, logits, NEG_INF)
    p = jax.nn.softmax(logits, axis=-1).astype(v_all.dtype)
    out = jnp.einsum('bhqk,bkhd->bqhd', p, v_all)
    return out.reshape(bsz, t, N_HEADS * HEAD_DIM)


def run_trunk(x, p, cache):
    bsz, s, _ = x.shape
    gmlp_v = []
    for l in range(DEPTH):
        if l == N_A_LAYERS:
            k_new, v_new, logf_new = shared_kv(x, p['kv_norm'], p['w_k'], p['w_v'], p['w_f'], p['b_f'])
            if cache is None:
                ctx = (k_new, v_new, logf_new)
            else:
                ctx = (jnp.concatenate([cache[0], k_new], axis=1),
                       jnp.concatenate([cache[1], v_new], axis=1),
                       jnp.concatenate([cache[2], logf_new], axis=1))
        x = half_ffn(x, p['ffn1_norm'][l], p['ffn1_w_gate'][l], p['ffn1_w_up'][l], p['ffn1_w_down'][l])
        h = rmsnorm(x, p['mix_norm'][l])
        if l < N_A_LAYERS:
            a, vn = gmlp_mix(h, p['gmlp_w_in'][l], p['gmlp_ln_g'][l], p['gmlp_ln_b'][l],
                             p['gmlp_w_s'][l], p['gmlp_b_s'][l], p['gmlp_w_out'][l])
            gmlp_v.append(vn)
        else:
            j = l - N_A_LAYERS
            q = (h @ p['fox_w_q'][j]).reshape(bsz, s, N_HEADS, HEAD_DIM)
            if cache is None:
                o = fox_prompt(q, ctx[0], ctx[1], ctx[2])
            else:
                o = fox_sample(q, ctx[0], ctx[1], ctx[2], cache[0].shape[1])
            a = o @ p['fox_w_o'][j]
        x = x + a
        x = half_ffn(x, p['ffn2_norm'][l], p['ffn2_w_gate'][l], p['ffn2_w_up'][l], p['ffn2_w_down'][l])
    y = rmsnorm(x, p['final_norm'])
    return y, k_new, v_new, logf_new, gmlp_v


def setup_inputs(seed: int = 0) -> dict:
    key = jax.random.key(seed)
    ks = iter(jax.random.split(key, 40))

    def nrm(shape, scale):
        return scale * jax.random.normal(next(ks), shape, jnp.float32)

    def gain(shape):
        return 1.0 + 0.02 * jax.random.normal(next(ks), shape, jnp.float32)

    hw = N_HEADS * HEAD_DIM
    x_prompt = nrm((BATCH, SEQ, D_MODEL), 1.0)
    x_sample = nrm((DEC_BATCH, DEC_SEQ, D_MODEL), 1.0)
    cache_k = nrm((DEC_BATCH, PAST_LEN, N_HEADS, HEAD_DIM), 1.0)
    cache_v = nrm((DEC_BATCH, PAST_LEN, N_HEADS, HEAD_DIM), 1.0)
    b_f = jax.random.uniform(next(ks), (N_HEADS,), jnp.float32, 1.0, 6.0)
    cache_logf = jax.nn.log_sigmoid(b_f + nrm((DEC_BATCH, PAST_LEN, N_HEADS), 1.0))
    return {
        'x_prompt': x_prompt,
        'x_sample': x_sample,
        'cache_k': cache_k,
        'cache_v': cache_v,
        'cache_logf': cache_logf,
        'ffn1_norm': gain((DEPTH, D_MODEL)),
        'ffn1_w_gate': nrm((DEPTH, D_MODEL, D_FF), D_MODEL ** -0.5),
        'ffn1_w_up': nrm((DEPTH, D_MODEL, D_FF), D_MODEL ** -0.5),
        'ffn1_w_down': nrm((DEPTH, D_FF, D_MODEL), D_FF ** -0.5),
        'mix_norm': gain((DEPTH, D_MODEL)),
        'ffn2_norm': gain((DEPTH, D_MODEL)),
        'ffn2_w_gate': nrm((DEPTH, D_MODEL, D_FF), D_MODEL ** -0.5),
        'ffn2_w_up': nrm((DEPTH, D_MODEL, D_FF), D_MODEL ** -0.5),
        'ffn2_w_down': nrm((DEPTH, D_FF, D_MODEL), D_FF ** -0.5),
        'gmlp_w_in': nrm((N_A_LAYERS, D_MODEL, 2 * D_GATE), D_MODEL ** -0.5),
        'gmlp_ln_g': gain((N_A_LAYERS, D_GATE)),
        'gmlp_ln_b': nrm((N_A_LAYERS, D_GATE), 0.02),
        'gmlp_w_s': nrm((N_A_LAYERS, GMLP_GROUPS, GMLP_CHUNK, GMLP_CHUNK), GMLP_CHUNK ** -0.5),
        'gmlp_b_s': 1.0 + nrm((N_A_LAYERS, GMLP_GROUPS, GMLP_CHUNK), 0.1),
        'gmlp_w_out': nrm((N_A_LAYERS, D_GATE, D_MODEL), D_GATE ** -0.5),
        'kv_norm': gain((D_MODEL,)),
        'w_k': nrm((D_MODEL, hw), D_MODEL ** -0.5),
        'w_v': nrm((D_MODEL, hw), D_MODEL ** -0.5),
        'w_f': nrm((D_MODEL, N_HEADS), 0.5 * D_MODEL ** -0.5),
        'b_f': b_f,
        'fox_w_q': nrm((N_B_LAYERS, D_MODEL, hw), D_MODEL ** -0.5),
        'fox_w_o': nrm((N_B_LAYERS, hw, D_MODEL), hw ** -0.5),
        'final_norm': gain((D_MODEL,)),
    }


def reference(x_prompt, x_sample, cache_k, cache_v, cache_logf,
              ffn1_norm, ffn1_w_gate, ffn1_w_up, ffn1_w_down, mix_norm,
              ffn2_norm, ffn2_w_gate, ffn2_w_up, ffn2_w_down,
              gmlp_w_in, gmlp_ln_g, gmlp_ln_b, gmlp_w_s, gmlp_b_s, gmlp_w_out,
              kv_norm, w_k, w_v, w_f, b_f, fox_w_q, fox_w_o, final_norm):
    p = dict(ffn1_norm=ffn1_norm, ffn1_w_gate=ffn1_w_gate, ffn1_w_up=ffn1_w_up, ffn1_w_down=ffn1_w_down,
             mix_norm=mix_norm, ffn2_norm=ffn2_norm, ffn2_w_gate=ffn2_w_gate, ffn2_w_up=ffn2_w_up,
             ffn2_w_down=ffn2_w_down, gmlp_w_in=gmlp_w_in, gmlp_ln_g=gmlp_ln_g, gmlp_ln_b=gmlp_ln_b,
             gmlp_w_s=gmlp_w_s, gmlp_b_s=gmlp_b_s, gmlp_w_out=gmlp_w_out, kv_norm=kv_norm,
             w_k=w_k, w_v=w_v, w_f=w_f, b_f=b_f, fox_w_q=fox_w_q, fox_w_o=fox_w_o, final_norm=final_norm)
    y_prompt, k_prompt, v_prompt, logf_prompt, _ = run_trunk(x_prompt, p, None)
    y_sample, k_sample, v_sample, logf_sample, gv = run_trunk(x_sample, p, (cache_k, cache_v, cache_logf))
    gmlp_v_sample = jnp.stack(gv, axis=0)
    return (y_prompt, y_sample, k_prompt, v_prompt, logf_prompt,
            k_sample, v_sample, logf_sample, gmlp_v_sample)
```

```cpp
#include <hip/hip_runtime.h>
#include <cstdio>
#include <cstdint>

#ifndef DIS
#define DIS 0
#endif
#ifndef REP_MASK
#define REP_MASK 0
#endif
#define REPS(bit) ((REP_MASK & (bit)) ? 2 : 1)
#ifndef MK_PER_PHASE
#define MK_PER_PHASE 0
#endif

#define LAS __attribute__((address_space(3)))
#define GAS __attribute__((address_space(1)))
typedef unsigned short bf16;
typedef short bf16x8 __attribute__((ext_vector_type(8)));
typedef short s16x4 __attribute__((ext_vector_type(4)));
typedef float f32x2 __attribute__((ext_vector_type(2)));
typedef float f32x4 __attribute__((ext_vector_type(4)));
typedef float f32x16 __attribute__((ext_vector_type(16)));
typedef unsigned u32x4 __attribute__((ext_vector_type(4)));
typedef unsigned u32x2 __attribute__((ext_vector_type(2)));
typedef GAS unsigned gu32;

constexpr int DM = 2048, SEQ = 8192, NSAMP = 256, M = SEQ + NSAMP, FF = 5632, DG = 4096, NH = 16, HD = 128, PAST = 2048, DEC_T = 16, DEC_B = 16;
constexpr float RMS_EPS = 1e-6f, LN_EPS = 1e-5f, LOG2E = 1.4426950408889634f, LN2 = 0.6931471805599453f;
constexpr int CKS_STRIDE = 2112;
constexpr size_t O_YP = 0, O_YS = O_YP + (size_t)SEQ * DM, O_KP = O_YS + (size_t)NSAMP * DM, O_VP = O_KP + (size_t)SEQ * DM, O_LP = O_VP + (size_t)SEQ * DM,
                 O_KS = O_LP + (size_t)SEQ * NH, O_VS = O_KS + (size_t)NSAMP * DM, O_LS = O_VS + (size_t)NSAMP * DM, O_GV = O_LS + (size_t)NSAMP * NH, O_END = O_GV + (size_t)2 * NSAMP * DG;
constexpr size_t MiB = 1u << 20;
constexpr size_t WS_CTL = 0, CTL_ZERO_BYTES = 64 * 1024;
constexpr size_t WS_WGU = 1 * MiB, SZ_WGU = 44 * MiB, WS_WD = WS_WGU + 8 * SZ_WGU, SZ_WD = 22 * MiB, WS_WIN = WS_WD + 8 * SZ_WD, SZ_WIN = 32 * MiB, WS_WOUT = WS_WIN + 2 * SZ_WIN, SZ_WOUT = 16 * MiB,
                 WS_WKV = WS_WOUT + 2 * SZ_WOUT, WS_WQ = WS_WKV + 16 * MiB, SZ_WQ = 8 * MiB, WS_WO = WS_WQ + 2 * SZ_WQ, WS_X = WS_WO + 2 * SZ_WQ, WS_XB = WS_X + 66 * MiB, WS_ACT = WS_XB + 33 * MiB,
                 WS_U = WS_ACT + 91 * MiB, WS_V = WS_U + 66 * MiB, WS_G = WS_V + 66 * MiB, WS_QB = WS_G + 66 * MiB, WS_KB = WS_QB + 33 * MiB, WS_VB = WS_KB + 33 * MiB, WS_OB = WS_VB + 33 * MiB,
                 WS_P = WS_OB + 33 * MiB, WS_S1 = WS_P + 2 * MiB, WS_LOGF = WS_S1 + 5 * MiB, WS_KX = WS_LOGF + 1 * MiB, WS_CKS = WS_KX + 2 * MiB, WS_CEND = WS_CKS + 3 * MiB, WS_SLAB = WS_CEND + 1 * MiB, WS_END = WS_SLAB + 128 * MiB;
static_assert((size_t)11264 * 2048 * 2 == SZ_WGU && (size_t)2048 * 5632 * 2 == SZ_WD && (size_t)M * DM * 4 == 66 * MiB && (size_t)M * FF * 2 <= 91 * MiB && (size_t)M * DG * 2 == 66 * MiB, "ws map");
static_assert((size_t)M * 32 * 4 <= 2 * MiB && (size_t)M * 64 * 8 <= 5 * MiB && (size_t)NH * SEQ * 4 <= 2 * MiB && (size_t)256 * CKS_STRIDE * 4 <= 3 * MiB, "ws map 2");
constexpr int CW_BAR = 4096;
constexpr int CW_TK = 8192, CW_KN2 = 8192 + 1024;
constexpr int RING_BYTES = 131072, RTAB_OFF = RING_BYTES, RTAB_BYTES = 8 * 256 * 4, MISC_OFF = RTAB_OFF + RTAB_BYTES, LDS_BYTES = 147456;
constexpr int NWAVES = 8;

__device__ __forceinline__ unsigned cvt_pk_bf16(float lo, float hi) { unsigned r; asm volatile("v_cvt_pk_bf16_f32 %0, %1, %2" : "=v"(r) : "v"(lo), "v"(hi)); return r; }
__device__ __forceinline__ unsigned f2bf(float f) { unsigned u = __builtin_bit_cast(unsigned, f); return (u + 0x7fffu + ((u >> 16) & 1u)) >> 16; }
__device__ __forceinline__ float bf2f(unsigned b) { return __builtin_bit_cast(float, b << 16); }
__device__ __forceinline__ unsigned pk2(float lo, float hi) { return f2bf(lo) | (f2bf(hi) << 16); }
#define LDS_WAIT() asm volatile("s_waitcnt lgkmcnt(0)" ::: "memory")
#define VM_WAIT() asm volatile("s_waitcnt vmcnt(0)" ::: "memory")
template <int X> __device__ __forceinline__ float xor_get(float v) { static_assert(X == 1 || X == 2 || X == 4 || X == 8 || X == 16, "swizzle xor"); return __builtin_bit_cast(float, __builtin_amdgcn_ds_swizzle(__builtin_bit_cast(int, v), 0x1F | (X << 10))); }
__device__ __forceinline__ float sum32(float v) { auto rr = __builtin_amdgcn_permlane32_swap(__float_as_uint(v), __float_as_uint(v), false, false); return __uint_as_float(rr[0]) + __uint_as_float(rr[1]); }
__device__ __forceinline__ float max32(float v) { auto rr = __builtin_amdgcn_permlane32_swap(__float_as_uint(v), __float_as_uint(v), false, false); return fmaxf(__uint_as_float(rr[0]), __uint_as_float(rr[1])); }
__device__ __forceinline__ float lane_get(float v, int src_lane) { return __builtin_bit_cast(float, __builtin_amdgcn_ds_bpermute(src_lane << 2, __builtin_bit_cast(int, v))); }
__device__ __forceinline__ float wave_sum(float v) { v += xor_get<1>(v); v += xor_get<2>(v); v += xor_get<4>(v); v += xor_get<8>(v); v += xor_get<16>(v); return sum32(v); }
__device__ __forceinline__ f32x2 gelu_pk(f32x2 v) {
    const f32x2 av = __builtin_elementwise_abs(v), d = av * 0.2316418882f + 1.0f;
    f32x2 t; t.x = __builtin_amdgcn_rcpf(d.x); t.y = __builtin_amdgcn_rcpf(d.y);
    f32x2 q = t * 0.5307027145f + (-0.7265760135f); q = q * t + 0.7107068705f; q = q * t + (-0.142248368f); q = q * t + 0.127414796f; q = q * t;
    const f32x2 s = (v * v) * (-0.72134752044f);
    f32x2 e; e.x = __builtin_amdgcn_exp2f(s.x); e.y = __builtin_amdgcn_exp2f(s.y);
    const f32x2 m = v * (q * e), r = v - m;
    f32x2 o; o.x = v.x < 0.f ? m.x : r.x; o.y = v.y < 0.f ? m.y : r.y; return o;
}
__device__ __forceinline__ float silu_f(float x) { return x * __builtin_amdgcn_rcpf(1.0f + __builtin_amdgcn_exp2f(-x * LOG2E)); }

namespace pg8 {
constexpr int BM = 256, BK = 64, HALF = 128, HTB = HALF * BK * 2, STAGE_BYTES = 8 * HTB, NXCD = 8, WGM = 8;
__host__ __device__ __forceinline__ int lds_byte(int r, int c) { const int st = (r >> 4) * 2 + (c >> 5), rr = r & 15, cc = c & 31, ob = rr * 64 + cc * 2; return st * 1024 + (ob ^ (((ob >> 9) & 1) << 5)); }
__host__ __device__ __forceinline__ void stage_rc(int b, int& R, int& C) { const int st = b / 1024, sb = b % 1024, swz = sb ^ (((sb >> 9) & 1) << 5); R = (st >> 1) * 16 + swz / 64; C = (st & 1) * 32 + (swz % 64) / 2; }
__host__ __device__ __forceinline__ int perm32(int rho) { const int n = rho >> 4, i = rho & 15; return 8 * (i >> 2) + 4 * n + (i & 3); }
struct Unit { int pm, pn, sw; };
struct Gemm { const bf16* A; const bf16* Bt; int M, N, K; };
struct Seg { int pm, pn, t0, t1, slot; };
struct HybridOrder {
    int nM, nN, nwg, G, c, T, q, R, lo, hi; bool split;
    __device__ __forceinline__ void init(int M_, int N_, int K_, int G_, int c_, bool split_) { nM = M_ / BM; nN = N_ / BM; nwg = nM * nN; G = G_; c = c_; T = K_ / (2 * BK); q = nwg / G; R = nwg - q * G; split = split_ && R > 0;
        const long W = (long)R * T; lo = (int)((long)c * W / G); hi = (int)((long)(c + 1) * W / G); }
    __device__ __forceinline__ void decode(int L, int& pm, int& pn) const {
        int wgid = L; { const int qq = nwg / NXCD, r = nwg % NXCD, xcd = wgid % NXCD, off = wgid / NXCD; wgid = (xcd < r ? xcd * (qq + 1) : r * (qq + 1) + (xcd - r) * qq) + off; }
        const int nig = WGM * nN, gid = wgid / nig, fm = gid * WGM, gsz = (nM - fm) < WGM ? (nM - fm) : WGM;
        pm = fm + ((wgid % nig) % gsz); pn = (wgid % nig) / gsz;
    }
    __device__ __forceinline__ bool seg(int i, Seg& s) const {
        if (!split || i < q) { const int L = i * G + c; if (L >= nwg) return false; decode(L, s.pm, s.pn); s.t0 = 0; s.t1 = T; s.slot = -1; return true; }
        const int j = i - q, r = lo / T + j, b = r * T; const int st = lo > b ? lo : b, en = hi < b + T ? hi : b + T; if (st >= en) return false;
        decode(q * G + r, s.pm, s.pn); s.t0 = st - b; s.t1 = en - b; s.slot = j; return true;
    }
};
struct NoSEpi { static constexpr bool ON = false; };
constexpr int SOFF = MISC_OFF + 4096;
template <class Epi, bool ALIGN_EPI = true, bool SP2 = true, class SEpi = NoSEpi>
__device__ __forceinline__ void gemm_phase(LAS unsigned char* lds, const Gemm g, const HybridOrder& S, const Epi& E, unsigned char* slab, int tid_, const SEpi& SE = SEpi()) {
    constexpr bool SAMP = SEpi::ON;
    static_assert(!SAMP || (SP2 && ALIGN_EPI), "sample piece: SP2 path only");
    asm volatile("" : "+v"(tid_));
    const int tid = tid_, wid = __builtin_amdgcn_readfirstlane(tid >> 6), lane = tid & 63, wr = wid >> 2, wc = wid & 3, fr = lane & 15, fq = lane >> 4;
    const int K = g.K;
    unsigned voffA[2], voffB[2];
#pragma unroll
    for (int i = 0; i < 2; ++i) { int R, C; stage_rc(tid * 16 + i * 8192, R, C); const int Rb = Epi::PERM ? ((R & ~31) + perm32(R & 31)) : R;
        voffA[i] = (unsigned)(R * K + C) * 2u; voffB[i] = (unsigned)(Rb * K + C) * 2u; }
    unsigned voffS = 0u; int soff = 0;
    if constexpr (SAMP) { int R, C; stage_rc(wid * 256 + lane * 4, R, C); voffS = (unsigned)(R * K + C) * 2u; soff = lds_byte(fr, fq * 8); }
    const size_t kstep = (size_t)(BK * 2);
    const size_t hstep = (size_t)HALF * K * 2;
    const size_t tstep = 2 * hstep;
    const unsigned ldsw = (unsigned)wid * 1024u;
    const int aoff = lds_byte(wr * 64 + fr, fq * 8), boff = lds_byte(wc * 32 + fr, fq * 8);
#define PG8_SA(b, h) (((b) * 2 + (h)) * HTB)
#define PG8_SB(b, h) ((4 + (b) * 2 + (h)) * HTB)
#define PG8_STAGE(bufoff, gbase, voff) do { _Pragma("unroll") for (int _i = 0; _i < 2; ++_i) \
        __builtin_amdgcn_global_load_lds((const unsigned*)((const char*)(gbase) + (voff)[_i]), (LAS unsigned*)(lds + (bufoff) + ldsw + _i * 8192), 16, 0, 0); } while (0)
#define PG8_LDA(dst, b, h) do { _Pragma("unroll") for (int m = 0; m < 4; ++m) _Pragma("unroll") for (int k = 0; k < 2; ++k) dst[m][k] = *(const LAS bf16x8*)(lds + PG8_SA(b, h) + aoff + m * 2048 + k * 1024); } while (0)
#define PG8_LDB(dst, b, h) do { _Pragma("unroll") for (int n = 0; n < 2; ++n) _Pragma("unroll") for (int k = 0; k < 2; ++k) dst[n][k] = *(const LAS bf16x8*)(lds + PG8_SB(b, h) + boff + n * 2048 + k * 1024); } while (0)
#define PG8_MMA(ai, bj, At, Bt) do { __builtin_amdgcn_s_setprio(1); _Pragma("unroll") for (int m = 0; m < 4; ++m) _Pragma("unroll") for (int n = 0; n < 2; ++n) _Pragma("unroll") for (int k = 0; k < 2; ++k) \
        acc[ai][bj][m][n] = __builtin_amdgcn_mfma_f32_16x16x32_bf16(Bt[n][k], At[m][k], acc[ai][bj][m][n], 0, 0, 0); __builtin_amdgcn_s_setprio(0); } while (0)
#define PG8_SS(b) (SOFF + (b) * 2048)
#define PG8_STAGE_S(b, gbase) do { if constexpr (SAMP) __builtin_amdgcn_global_load_lds((const unsigned*)((const char*)(gbase) + voffS), (LAS unsigned*)(lds + PG8_SS(b) + wid * 256), 4, 0, 0); } while (0)
#define PG8_LDS_S(b) do { if constexpr (SAMP) { As_[0] = *(const LAS bf16x8*)(lds + PG8_SS(b) + soff); As_[1] = *(const LAS bf16x8*)(lds + PG8_SS(b) + soff + 1024); Bs_[0] = wr ? B1[1][0] : B1[0][0]; Bs_[1] = wr ? B1[1][1] : B1[0][1]; } } while (0)
#define PG8_MS(Bx, n_) do { acc2 = __builtin_amdgcn_mfma_f32_16x16x32_bf16(Bx[n_][0], As_[0], acc2, 0, 0, 0); acc2 = __builtin_amdgcn_mfma_f32_16x16x32_bf16(Bx[n_][1], As_[1], acc2, 0, 0, 0); } while (0)
#define PG8_MMA_S() do { asm volatile("" : "+v"(As_[0]), "+v"(As_[1]), "+v"(Bs_[0]), "+v"(Bs_[1])); __builtin_amdgcn_s_setprio(1); acc2 = __builtin_amdgcn_mfma_f32_16x16x32_bf16(Bs_[0], As_[0], acc2, 0, 0, 0); acc2 = __builtin_amdgcn_mfma_f32_16x16x32_bf16(Bs_[1], As_[1], acc2, 0, 0, 0); __builtin_amdgcn_s_setprio(0); asm volatile("" : "+v"(acc2)); } while (0)
#define PG8_WAIT_VS(n, ns) do { if constexpr (SAMP) asm volatile("s_waitcnt vmcnt(" #ns ")" ::: "memory"); else asm volatile("s_waitcnt vmcnt(" #n ")" ::: "memory"); } while (0)
#define PG8_WAIT_V(n) asm volatile("s_waitcnt vmcnt(" #n ")" ::: "memory")
#define PG8_WAIT_L(n) asm volatile("s_waitcnt lgkmcnt(" #n ")" ::: "memory")
#define PG8_BAR __builtin_amdgcn_s_barrier()
#define PG8_SCHED __builtin_amdgcn_sched_barrier(0)
    Seg cur, nxt; int ui = 0;
    if (!S.seg(0, cur)) return;
    f32x4 acc[2][2][4][2];
#pragma unroll
    for (int a = 0; a < 2; ++a)
#pragma unroll
        for (int b = 0; b < 2; ++b)
#pragma unroll
            for (int m = 0; m < 4; ++m)
#pragma unroll
                for (int n = 0; n < 2; ++n) acc[a][b][m][n] = (f32x4){0.f, 0.f, 0.f, 0.f};
    bf16x8 At[4][2], B0[2][2], B1[2][2];
    bf16x8 As_[2], Bs_[2]; f32x4 acc2 = (f32x4){0.f, 0.f, 0.f, 0.f}; (void)As_; (void)Bs_; (void)acc2;
    const size_t sstep = (size_t)16 * K * 2;
    const char* sbase = (const char*)g.A + (size_t)SEQ * K * 2;
    const char* cS = sbase + (size_t)(cur.pm >> 1) * sstep; (void)cS;
    const char* cA = (const char*)g.A + (size_t)cur.pm * tstep + (size_t)cur.t0 * 2 * kstep; const char* cB = (const char*)g.Bt + (size_t)cur.pn * tstep + (size_t)cur.t0 * 2 * kstep;
    long cD = (long)hstep;
    if constexpr (SAMP) { if (!(cur.pm & 1)) { cB += hstep; cD = -(long)hstep; } }
    if constexpr (SAMP) {
        PG8_STAGE(PG8_SB(0, 0), cB, voffB); PG8_STAGE(PG8_SB(0, 1), cB + cD, voffB); PG8_STAGE(PG8_SA(0, 0), cA, voffA); PG8_STAGE_S(0, cS); PG8_STAGE(PG8_SA(0, 1), cA + hstep, voffA);
        if (wr == 1) PG8_BAR;
        PG8_WAIT_V(2); PG8_BAR;
        PG8_STAGE(PG8_SB(1, 0), cB + kstep, voffB); PG8_STAGE(PG8_SA(1, 0), cA + kstep, voffA); PG8_STAGE(PG8_SB(1, 1), cB + cD + kstep, voffB);
        PG8_WAIT_V(6); PG8_BAR;
    } else if constexpr (SP2) {
        PG8_STAGE(PG8_SB(0, 0), cB, voffB); PG8_STAGE(PG8_SB(0, 1), cB + hstep, voffB); PG8_STAGE(PG8_SA(0, 0), cA, voffA); PG8_STAGE(PG8_SA(0, 1), cA + hstep, voffA);
        if (wr == 1) PG8_BAR;
        PG8_WAIT_V(2); PG8_BAR;
        PG8_STAGE(PG8_SB(1, 0), cB + kstep, voffB); PG8_STAGE(PG8_SA(1, 0), cA + kstep, voffA); PG8_STAGE(PG8_SB(1, 1), cB + hstep + kstep, voffB);
        PG8_WAIT_V(6); PG8_BAR;
    } else {
        PG8_STAGE(PG8_SB(0, 0), cB, voffB); PG8_STAGE(PG8_SA(0, 0), cA, voffA); PG8_STAGE(PG8_SB(0, 1), cB + hstep, voffB); PG8_STAGE(PG8_SA(0, 1), cA + hstep, voffA);
        if (wr == 1) PG8_BAR;
        PG8_WAIT_V(4); PG8_BAR;
        PG8_STAGE(PG8_SB(1, 0), cB + kstep, voffB); PG8_STAGE(PG8_SA(1, 0), cA + kstep, voffA); PG8_STAGE(PG8_SB(1, 1), cB + hstep + kstep, voffB);
        PG8_WAIT_V(6); PG8_BAR;
    }
    for (;;) {
        const bool has_next = S.seg(ui + 1, nxt);
        const char* nA = has_next ? (const char*)g.A + (size_t)nxt.pm * tstep + (size_t)nxt.t0 * 2 * kstep : cA; const char* nB = has_next ? (const char*)g.Bt + (size_t)nxt.pn * tstep + (size_t)nxt.t0 * 2 * kstep : cB;
        const char* nS = has_next ? sbase + (size_t)(nxt.pm >> 1) * sstep : cS; (void)nS;
        long nD = cD; if constexpr (SAMP) { if (has_next) { nD = (long)hstep; if (!(nxt.pm & 1)) { nB += hstep; nD = -(long)hstep; } } }
        const int nt = 2 * (cur.t1 - cur.t0);
        for (int t = 0; t < nt; t += 2) {
            const bool last = (t == nt - 2);
            const char* a1 = cA + (size_t)(t + 1) * kstep;
            const char* a2 = last ? nA : cA + (size_t)(t + 2) * kstep; const char* b2 = last ? nB : cB + (size_t)(t + 2) * kstep;
            const char* a3 = a2 + kstep; const char* b3 = b2 + kstep;
            if constexpr (SAMP) {
            const char* s1 = cS + (size_t)(t + 1) * kstep; const char* s2 = last ? nS : cS + (size_t)(t + 2) * kstep; const long d2 = last ? nD : cD;
            PG8_LDB(B0, 0, 0); PG8_LDB(B1, 0, 1); PG8_SCHED; PG8_LDA(At, 0, 0); PG8_STAGE(PG8_SA(1, 1), a1 + hstep, voffA);
            PG8_WAIT_V(8); PG8_WAIT_L(0); PG8_BAR; PG8_STAGE_S(1, s1); PG8_MMA(0, 0, At, B0); PG8_MMA(0, 1, At, B1); PG8_BAR; PG8_SCHED;
            PG8_LDA(At, 0, 1); PG8_STAGE(PG8_SB(0, 0), b2, voffB); PG8_STAGE(PG8_SB(0, 1), b2 + d2, voffB); PG8_STAGE(PG8_SA(0, 0), a2, voffA);
            PG8_WAIT_V(9); PG8_WAIT_L(0); PG8_BAR; PG8_MMA(1, 0, At, B0); PG8_SCHED; PG8_LDS_S(0); PG8_SCHED; PG8_MMA(1, 1, At, B1); PG8_WAIT_L(0); PG8_MMA_S(); PG8_BAR; PG8_SCHED;
            PG8_LDB(B0, 1, 0); PG8_LDB(B1, 1, 1); PG8_SCHED; PG8_LDA(At, 1, 0); PG8_STAGE(PG8_SA(0, 1), a2 + hstep, voffA);
            PG8_WAIT_V(8); PG8_WAIT_L(0); PG8_BAR; PG8_STAGE_S(0, s2); PG8_MMA(0, 0, At, B0); PG8_MMA(0, 1, At, B1); PG8_BAR; PG8_SCHED;
            PG8_LDA(At, 1, 1); PG8_STAGE(PG8_SB(1, 0), b3, voffB); PG8_STAGE(PG8_SB(1, 1), b3 + d2, voffB); PG8_STAGE(PG8_SA(1, 0), a3, voffA);
            PG8_WAIT_V(9); PG8_WAIT_L(0); PG8_BAR; PG8_MMA(1, 0, At, B0); PG8_SCHED; PG8_LDS_S(1); PG8_SCHED; PG8_MMA(1, 1, At, B1); PG8_WAIT_L(0); PG8_MMA_S(); PG8_BAR; PG8_SCHED;
            } else if constexpr (SP2) {
            PG8_LDB(B0, 0, 0); PG8_LDB(B1, 0, 1); PG8_SCHED; PG8_LDA(At, 0, 0); PG8_STAGE(PG8_SA(1, 1), a1 + hstep, voffA);
            PG8_WAIT_V(8); PG8_WAIT_L(0); PG8_BAR; PG8_MMA(0, 0, At, B0); PG8_MMA(0, 1, At, B1); PG8_BAR; PG8_SCHED;
            PG8_LDA(At, 0, 1); PG8_STAGE(PG8_SB(0, 0), b2, voffB); PG8_STAGE(PG8_SB(0, 1), b2 + hstep, voffB); PG8_STAGE(PG8_SA(0, 0), a2, voffA);
            PG8_WAIT_V(8); PG8_WAIT_L(0); PG8_BAR; PG8_MMA(1, 0, At, B0); PG8_MMA(1, 1, At, B1); PG8_BAR; PG8_SCHED;
            PG8_LDB(B0, 1, 0); PG8_LDB(B1, 1, 1); PG8_SCHED; PG8_LDA(At, 1, 0); PG8_STAGE(PG8_SA(0, 1), a2 + hstep, voffA);
            PG8_WAIT_V(8); PG8_WAIT_L(0); PG8_BAR; PG8_MMA(0, 0, At, B0); PG8_MMA(0, 1, At, B1); PG8_BAR; PG8_SCHED;
            PG8_LDA(At, 1, 1); PG8_STAGE(PG8_SB(1, 0), b3, voffB); PG8_STAGE(PG8_SB(1, 1), b3 + hstep, voffB); PG8_STAGE(PG8_SA(1, 0), a3, voffA);
            PG8_WAIT_V(8); PG8_WAIT_L(0); PG8_BAR; PG8_MMA(1, 0, At, B0); PG8_MMA(1, 1, At, B1); PG8_BAR; PG8_SCHED;
            } else {
            PG8_LDB(B0, 0, 0); PG8_SCHED; PG8_LDA(At, 0, 0); PG8_STAGE(PG8_SA(1, 1), a1 + hstep, voffA);
            PG8_WAIT_L(8); PG8_BAR; PG8_WAIT_L(0); PG8_MMA(0, 0, At, B0); PG8_BAR; PG8_SCHED;
            PG8_LDB(B1, 0, 1); PG8_STAGE(PG8_SB(0, 0), b2, voffB);
            PG8_BAR; PG8_WAIT_L(0); PG8_MMA(0, 1, At, B1); PG8_BAR;
            PG8_LDA(At, 0, 1); PG8_STAGE(PG8_SA(0, 0), a2, voffA);
            PG8_BAR; PG8_WAIT_L(0); PG8_MMA(1, 0, At, B0); PG8_BAR; PG8_SCHED;
            PG8_STAGE(PG8_SB(0, 1), b2 + hstep, voffB);
            PG8_WAIT_V(6); PG8_BAR; PG8_MMA(1, 1, At, B1); PG8_BAR;
            PG8_LDB(B0, 1, 0); PG8_SCHED; PG8_LDA(At, 1, 0); PG8_STAGE(PG8_SA(0, 1), a2 + hstep, voffA);
            PG8_WAIT_L(8); PG8_BAR; PG8_WAIT_L(0); PG8_MMA(0, 0, At, B0); PG8_BAR; PG8_SCHED;
            PG8_LDB(B1, 1, 1); PG8_STAGE(PG8_SB(1, 0), b3, voffB);
            PG8_BAR; PG8_WAIT_L(0); PG8_MMA(0, 1, At, B1); PG8_BAR;
            PG8_LDA(At, 1, 1); PG8_STAGE(PG8_SA(1, 0), a3, voffA);
            PG8_BAR; PG8_WAIT_L(0); PG8_MMA(1, 0, At, B0); PG8_BAR; PG8_SCHED;
            PG8_STAGE(PG8_SB(1, 1), b3 + hstep, voffB);
            PG8_WAIT_V(6); PG8_BAR; PG8_MMA(1, 1, At, B1); PG8_BAR;
            }
        }
        if constexpr (ALIGN_EPI) { if (wr == 0) PG8_BAR; }
        if (cur.slot >= 0) {
            const __amdgpu_buffer_rsrc_t rs = __builtin_amdgcn_make_buffer_rsrc((void*)(slab + (size_t)(S.c * 2 + cur.slot) * 262144), 0, 262144, 0x00020000);
#pragma unroll
            for (int a = 0; a < 2; ++a)
#pragma unroll
                for (int b = 0; b < 2; ++b)
#pragma unroll
                    for (int m = 0; m < 4; ++m)
#pragma unroll
                        for (int n = 0; n < 2; ++n) { const int j = ((a * 2 + b) * 4 + m) * 2 + n;
                            __builtin_amdgcn_raw_buffer_store_b128(__builtin_bit_cast(u32x4, acc[a][b][m][n]), rs, (unsigned)(tid * 16), j * 8192, 0); }
        } else {
            const Unit un{cur.pm, cur.pn, SAMP ? ((cur.pm & 1) ^ 1) : 0};
            if constexpr (SAMP) { SE(acc2, un, ui, wid, wr, wc, fr, fq, tid); acc2 = (f32x4){0.f, 0.f, 0.f, 0.f}; }
            E(acc, un, ui, wr, wc, fr, fq);
        }
        if (!has_next) break;
#pragma unroll
        for (int a = 0; a < 2; ++a)
#pragma unroll
            for (int b = 0; b < 2; ++b)
#pragma unroll
                for (int m = 0; m < 4; ++m)
#pragma unroll
                    for (int n = 0; n < 2; ++n) acc[a][b][m][n] = (f32x4){0.f, 0.f, 0.f, 0.f};
        cur = nxt; cA = nA; cB = nB; ++ui; if constexpr (SAMP) { cS = nS; cD = nD; }
        if constexpr (ALIGN_EPI) { if (wr == 1) PG8_BAR; }
    }
    PG8_WAIT_V(0);
    if constexpr (!ALIGN_EPI) { if (wr == 0) PG8_BAR; }
    PG8_BAR;
#undef PG8_SA
#undef PG8_SB
#undef PG8_STAGE
#undef PG8_LDA
#undef PG8_LDB
#undef PG8_MMA
#undef PG8_WAIT_V
#undef PG8_WAIT_VS
#undef PG8_SS
#undef PG8_STAGE_S
#undef PG8_LDS_S
#undef PG8_MS
#undef PG8_MMA_S
#undef PG8_WAIT_L
#undef PG8_BAR
#undef PG8_SCHED
}

typedef const f32x4 (&AccRef)[2][2][4][2];
struct EpiSwiGLU {
    static constexpr bool PERM = true;
    bf16* ACT; const LAS float* rtab;
    __device__ __forceinline__ void operator()(AccRef acc, const Unit& u, int ui, int wr, int wc, int fr, int fq) const {
        const int rl0 = wr * 64 + fr;
#pragma unroll
        for (int ai = 0; ai < 2; ++ai)
#pragma unroll
            for (int m = 0; m < 4; ++m) {
                const int rl = rl0 + ai * HALF + m * 16; const float r = rtab[(ui & 7) * 256 + rl];
                bf16* p = ACT + (size_t)(u.pm * BM + rl) * FF + u.pn * 128 + wc * 32 + 8 * fq;
                const float c = -r * LOG2E, rr = r * r; unsigned wv[4];
#pragma unroll
                for (int n = 0; n < 2; ++n)
#pragma unroll
                    for (int h2 = 0; h2 < 2; ++h2) { const f32x2 g2 = (f32x2){acc[ai][0][m][n][2 * h2], acc[ai][0][m][n][2 * h2 + 1]}, u2 = (f32x2){acc[ai][1][m][n][2 * h2], acc[ai][1][m][n][2 * h2 + 1]};
                        const f32x2 a2 = g2 * c; f32x2 e2; e2.x = __builtin_amdgcn_exp2f(a2.x); e2.y = __builtin_amdgcn_exp2f(a2.y);
                        const f32x2 d2 = e2 + 1.0f; f32x2 q2; q2.x = __builtin_amdgcn_rcpf(d2.x); q2.y = __builtin_amdgcn_rcpf(d2.y);
                        const f32x2 o2 = ((g2 * u2) * rr) * q2;
                        wv[n * 2 + h2] = cvt_pk_bf16(o2.x, o2.y); }
                u32x4 w; w.x = wv[0]; w.y = wv[1]; w.z = wv[2]; w.w = wv[3];
                *(u32x4*)p = w;
            }
    }
};
struct EpiResid {
    static constexpr bool PERM = true;
    bf16* XB; float* P; float alpha;
    __device__ __forceinline__ void rows(const f32x4 (&v)[2][2], const Unit& u, int ai, int m, int wr, int wc, int fr, int fq) const {
        const int row = u.pm * BM + wr * 64 + fr + ai * HALF + m * 16; const size_t off = (size_t)row * DM + u.pn * BM + wc * 32 + 8 * fq;
        float ss = 0.f;
#pragma unroll
        for (int bj = 0; bj < 2; ++bj) {
            const u32x4 xr = *(const u32x4*)(XB + off + (bj ^ u.sw) * HALF);
            const f32x4 x0 = (f32x4){bf2f(xr.x & 0xffffu), bf2f(xr.x >> 16), bf2f(xr.y & 0xffffu), bf2f(xr.y >> 16)}, x1 = (f32x4){bf2f(xr.z & 0xffffu), bf2f(xr.z >> 16), bf2f(xr.w & 0xffffu), bf2f(xr.w >> 16)};
            const f32x4 y0 = x0 + v[bj][0] * alpha, y1 = x1 + v[bj][1] * alpha;
            u32x4 w; w.x = cvt_pk_bf16(y0[0], y0[1]); w.y = cvt_pk_bf16(y0[2], y0[3]); w.z = cvt_pk_bf16(y1[0], y1[1]); w.w = cvt_pk_bf16(y1[2], y1[3]);
            *(u32x4*)(XB + off + (bj ^ u.sw) * HALF) = w;
            ss += (y0[0] * y0[0] + y0[1] * y0[1]) + (y0[2] * y0[2] + y0[3] * y0[3]) + (y1[0] * y1[0] + y1[1] * y1[1]) + (y1[2] * y1[2] + y1[3] * y1[3]);
        }
        ss += xor_get<16>(ss); ss = sum32(ss);
        if (fq == 0) P[(size_t)row * 32 + u.pn * 4 + wc] = ss;
    }
    __device__ __forceinline__ void operator()(AccRef acc, const Unit& u, int ui, int wr, int wc, int fr, int fq) const {
#pragma unroll
        for (int ai = 0; ai < 2; ++ai)
#pragma unroll
            for (int m = 0; m < 4; ++m) { const f32x4 v[2][2] = {{acc[ai][0][m][0], acc[ai][0][m][1]}, {acc[ai][1][m][0], acc[ai][1][m][1]}}; rows(v, u, ai, m, wr, wc, fr, fq); asm volatile("" ::: "memory"); }
    }
};
struct EpiGelu {
    static constexpr bool PERM = true;
    bf16* U; bf16* V; f32x2* S1; const LAS float* rtab;
    __device__ __forceinline__ void operator()(AccRef acc, const Unit& u, int ui, int wr, int wc, int fr, int fq) const {
        const int rl0 = wr * 64 + fr; const bool isv = u.pn >= 16; bf16* base = isv ? V : U; const int pc = u.pn & 15;
#pragma unroll
        for (int ai = 0; ai < 2; ++ai)
#pragma unroll
            for (int m = 0; m < 4; ++m) {
                const int rl = rl0 + ai * HALF + m * 16; const float r = rtab[(ui & 7) * 256 + rl]; const int row = u.pm * BM + rl;
                bf16* p = base + (size_t)row * DG + pc * BM + wc * 32 + 8 * fq;
                float s1 = 0.f, s2 = 0.f;
#pragma unroll
                for (int bj = 0; bj < 2; ++bj) {
                    const f32x4 v0 = acc[ai][bj][m][0] * r, v1 = acc[ai][bj][m][1] * r;
                    const f32x2 a = gelu_pk((f32x2){v0[0], v0[1]}), b = gelu_pk((f32x2){v0[2], v0[3]}), c = gelu_pk((f32x2){v1[0], v1[1]}), d = gelu_pk((f32x2){v1[2], v1[3]});
                    u32x4 w; w.x = cvt_pk_bf16(a.x, a.y); w.y = cvt_pk_bf16(b.x, b.y); w.z = cvt_pk_bf16(c.x, c.y); w.w = cvt_pk_bf16(d.x, d.y);
                    *(u32x4*)(p + (bj ^ u.sw) * HALF) = w;
                    s1 += (a.x + a.y) + (b.x + b.y) + (c.x + c.y) + (d.x + d.y);
                    s2 += (a.x * a.x + a.y * a.y) + (b.x * b.x + b.y * b.y) + (c.x * c.x + c.y * c.y) + (d.x * d.x + d.y * d.y);
                }
                if (isv) {
                    s1 += xor_get<16>(s1); s1 = sum32(s1); s2 += xor_get<16>(s2); s2 = sum32(s2);
                    if (fq == 0) S1[(size_t)row * 64 + pc * 4 + wc] = (f32x2){s1, s2};
                }
            }
    }
};
struct EpiQ {
    static constexpr bool PERM = true;
    bf16* O; const LAS float* rtab; const float* P;
    __device__ __forceinline__ void rows_r(const f32x4 (&v)[2][2], const Unit& u, float r, int ai, int m, int wr, int wc, int fr, int fq) const {
        const int rl = wr * 64 + fr + ai * HALF + m * 16;
        bf16* p = O + (size_t)(u.pm * BM + rl) * DM + u.pn * BM + wc * 32 + 8 * fq;
#pragma unroll
        for (int bj = 0; bj < 2; ++bj) {
            const f32x4 v0 = v[bj][0] * r, v1 = v[bj][1] * r;
            u32x4 w; w.x = cvt_pk_bf16(v0[0], v0[1]); w.y = cvt_pk_bf16(v0[2], v0[3]); w.z = cvt_pk_bf16(v1[0], v1[1]); w.w = cvt_pk_bf16(v1[2], v1[3]);
            *(u32x4*)(p + (bj ^ u.sw) * HALF) = w;
        }
    }
    __device__ __forceinline__ void rows(const f32x4 (&v)[2][2], const Unit& u, int ai, int m, int wr, int wc, int fr, int fq) const {
        const int row = u.pm * BM + wr * 64 + fr + ai * HALF + m * 16; const f32x4* p = (const f32x4*)(P + (size_t)row * 32); float s = 0.f;
#pragma unroll
        for (int i = 0; i < 8; ++i) { const f32x4 a = p[i]; s += (a[0] + a[1]) + (a[2] + a[3]); }
        rows_r(v, u, 1.0f / sqrtf(s * (1.0f / DM) + RMS_EPS), ai, m, wr, wc, fr, fq);
    }
    __device__ __forceinline__ void operator()(AccRef acc, const Unit& u, int ui, int wr, int wc, int fr, int fq) const {
#pragma unroll
        for (int ai = 0; ai < 2; ++ai)
#pragma unroll
            for (int m = 0; m < 4; ++m) { const f32x4 v[2][2] = {{acc[ai][0][m][0], acc[ai][0][m][1]}, {acc[ai][1][m][0], acc[ai][1][m][1]}};
                rows_r(v, u, rtab[(ui & 7) * 256 + wr * 64 + fr + ai * HALF + m * 16], ai, m, wr, wc, fr, fq); }
    }
};
struct EpiKV {
    static constexpr bool PERM = true;
    float* out; bf16* KB; bf16* VB; const LAS float* rtab;
    __device__ __forceinline__ void operator()(AccRef acc, const Unit& u, int ui, int wr, int wc, int fr, int fq) const {
        const int rl0 = wr * 64 + fr; const bool isv = u.pn >= 8; const int pc = u.pn & 7; const bool samp = u.pm >= SEQ / BM;
        float* fo = out + (samp ? (isv ? O_VS : O_KS) : (isv ? O_VP : O_KP)); bf16* bo = isv ? VB : KB;
#pragma unroll
        for (int ai = 0; ai < 2; ++ai)
#pragma unroll
            for (int m = 0; m < 4; ++m) {
                const int rl = rl0 + ai * HALF + m * 16; const float r = rtab[(ui & 7) * 256 + rl]; const int row = u.pm * BM + rl;
                const int col = pc * BM + wc * 32 + 8 * fq;
                float* fp = fo + (size_t)(samp ? row - SEQ : row) * DM + col; bf16* bp = bo + (size_t)row * DM + col;
#pragma unroll
                for (int bj = 0; bj < 2; ++bj) {
                    const f32x4 v0 = acc[ai][bj][m][0] * r, v1 = acc[ai][bj][m][1] * r;
                    *(f32x4*)(fp + bj * HALF) = v0; *(f32x4*)(fp + bj * HALF + 4) = v1;
                    u32x4 w; w.x = cvt_pk_bf16(v0[0], v0[1]); w.y = cvt_pk_bf16(v0[2], v0[3]); w.z = cvt_pk_bf16(v1[0], v1[1]); w.w = cvt_pk_bf16(v1[2], v1[3]);
                    *(u32x4*)(bp + bj * HALF) = w;
                }
            }
    }
};
__device__ __forceinline__ float row_rs(const float* P, int row) { const f32x4* p = (const f32x4*)(P + (size_t)row * 32); float s = 0.f;
#pragma unroll
    for (int i = 0; i < 8; ++i) { const f32x4 a = p[i]; s += (a[0] + a[1]) + (a[2] + a[3]); }
    return 1.0f / sqrtf(s * (1.0f / DM) + RMS_EPS); }
struct SEpiResid {
    static constexpr bool ON = true;
    bf16* XB; float* P; float alpha; LAS float* red;
    __device__ __forceinline__ void operator()(f32x4 v, const Unit& u, int ui, int wid, int wr, int wc, int fr, int fq, int tid) const {
        const int row0 = SEQ + 16 * (u.pm >> 1), col = u.pn * BM + (u.pm & 1) * HALF + wc * 32 + 8 * fq + 4 * wr;
        bf16* xp = XB + (size_t)(row0 + fr) * DM + col;
        const u32x2 xr = *(const u32x2*)xp;
        const f32x4 y = (f32x4){bf2f(xr.x & 0xffffu), bf2f(xr.x >> 16), bf2f(xr.y & 0xffffu), bf2f(xr.y >> 16)} + v * alpha;
        u32x2 w; w.x = cvt_pk_bf16(y[0], y[1]); w.y = cvt_pk_bf16(y[2], y[3]); *(u32x2*)xp = w;
        float ss = (y[0] * y[0] + y[1] * y[1]) + (y[2] * y[2] + y[3] * y[3]);
        ss += xor_get<16>(ss); ss = sum32(ss);
        if (fq == 0) red[wid * 16 + fr] = ss;
        LDS_WAIT(); __builtin_amdgcn_s_barrier(); asm volatile("" ::: "memory");
        if (tid < 32) { const int r = tid & 15, j = tid >> 4;
            const float s = (red[(2 * j) * 16 + r] + red[(2 * j + 1) * 16 + r]) + (red[(4 + 2 * j) * 16 + r] + red[(5 + 2 * j) * 16 + r]);
            P[(size_t)(row0 + r) * 32 + u.pn * 4 + (u.pm & 1) * 2 + j] = s; }
    }
};
struct SEpiQ {
    static constexpr bool ON = true;
    bf16* O; const LAS float* srt;
    __device__ __forceinline__ void operator()(f32x4 v, const Unit& u, int ui, int wid, int wr, int wc, int fr, int fq, int tid) const {
        const int row = SEQ + 16 * (u.pm >> 1) + fr, col = u.pn * BM + (u.pm & 1) * HALF + wc * 32 + 8 * fq + 4 * wr;
        const float r = srt[(ui & 7) * 16 + fr];
        u32x2 w; w.x = cvt_pk_bf16(v[0] * r, v[1] * r); w.y = cvt_pk_bf16(v[2] * r, v[3] * r); *(u32x2*)(O + (size_t)row * DM + col) = w;
    }
};
struct SEpiGelu {
    static constexpr bool ON = true;
    bf16* U; bf16* V; f32x2* S1; const LAS float* srt; LAS float* red;
    __device__ __forceinline__ void operator()(f32x4 v, const Unit& u, int ui, int wid, int wr, int wc, int fr, int fq, int tid) const {
        const bool isv = u.pn >= 16; const int pc = u.pn & 15;
        const int row0 = SEQ + 16 * (u.pm >> 1), col = pc * BM + (u.pm & 1) * HALF + wc * 32 + 8 * fq + 4 * wr;
        const float r = srt[(ui & 7) * 16 + fr];
        const f32x2 a = gelu_pk((f32x2){v[0] * r, v[1] * r}), b = gelu_pk((f32x2){v[2] * r, v[3] * r});
        u32x2 w; w.x = cvt_pk_bf16(a.x, a.y); w.y = cvt_pk_bf16(b.x, b.y); *(u32x2*)((isv ? V : U) + (size_t)(row0 + fr) * DG + col) = w;
        if (isv) {
            float s1 = (a.x + a.y) + (b.x + b.y), s2 = (a.x * a.x + a.y * a.y) + (b.x * b.x + b.y * b.y);
            s1 += xor_get<16>(s1); s1 = sum32(s1); s2 += xor_get<16>(s2); s2 = sum32(s2);
            if (fq == 0) { red[wid * 16 + fr] = s1; red[128 + wid * 16 + fr] = s2; }
            LDS_WAIT(); __builtin_amdgcn_s_barrier(); asm volatile("" ::: "memory");
            if (tid < 32) { const int rr = tid & 15, j = tid >> 4;
                const float t1 = (red[(2 * j) * 16 + rr] + red[(2 * j + 1) * 16 + rr]) + (red[(4 + 2 * j) * 16 + rr] + red[(5 + 2 * j) * 16 + rr]);
                const float t2 = (red[128 + (2 * j) * 16 + rr] + red[128 + (2 * j + 1) * 16 + rr]) + (red[128 + (4 + 2 * j) * 16 + rr] + red[128 + (5 + 2 * j) * 16 + rr]);
                S1[(size_t)(row0 + rr) * 64 + pc * 4 + (u.pm & 1) * 2 + j] = (f32x2){t1, t2}; }
        }
    }
};
}

#define XB_TMO      128
#define XB_XCNT(j)  (256  + 64 * (j))
#define XB_XSUB(j)  (1280 + 64 * (j))
#define XB_XGEN(j)  (2304 + 64 * (j))
#define XB_TOP      3328
#define XB_TOPGEN   3392
#define XCD_BAR_WORDS 3456
#define XB_SPIN_CAP (1u << 18)
__device__ __forceinline__ unsigned xb_ld(unsigned* p)              { return __hip_atomic_load(p, __ATOMIC_RELAXED, __HIP_MEMORY_SCOPE_AGENT); }
__device__ __forceinline__ unsigned xb_add(unsigned* p, unsigned v) { return __hip_atomic_fetch_add(p, v, __ATOMIC_RELAXED, __HIP_MEMORY_SCOPE_AGENT); }
__device__ __forceinline__ unsigned xb_xcc_id() { return (unsigned)__builtin_amdgcn_s_getreg((3 << 11) | 20) & 0xFu; }
#define XB_SPIN(cond, bar) do { unsigned _sp = 0; while (cond) { __builtin_amdgcn_s_sleep(1); \
    if ((++_sp & 255u) == 0u) { if (xb_ld(&(bar)[XB_TMO])) break; if (_sp > XB_SPIN_CAP) { atomicAdd(&(bar)[XB_TMO], 1u); break; } } } } while (0)
struct XcdBarrier { unsigned* bar; unsigned x; volatile LAS unsigned* st; };
__device__ __forceinline__ XcdBarrier xcd_barrier_post(unsigned* bar, volatile LAS unsigned* st) {
    XcdBarrier b; b.bar = bar; b.x = xb_xcc_id(); b.st = st;
    if (threadIdx.x == 0) (void)xb_add(&bar[XB_XCNT(b.x)], 1u);
    return b;
}
__device__ __forceinline__ void xcd_barrier_complete(unsigned* bar, unsigned x, unsigned& nloc, unsigned& nx) {
    const unsigned G = gridDim.x * gridDim.y * gridDim.z;
    unsigned sum, cnt, mine, sp = 0u;
    for (;;) {
        sum = 0u; cnt = 0u; mine = 0u;
#pragma unroll
        for (unsigned j = 0; j < 16; ++j) { const unsigned c = xb_ld(&bar[XB_XCNT(j)]); sum += c; cnt += (c > 0u) ? 1u : 0u; mine = (j == x) ? c : mine; }
        if (sum == G) break;
        __builtin_amdgcn_s_sleep(1);
        if ((++sp & 255u) == 0u) { if (xb_ld(&bar[XB_TMO])) break; if (sp > XB_SPIN_CAP) { atomicAdd(&bar[XB_TMO], 1u); break; } }
    }
    nloc = mine > 0u ? mine : 1u; nx = cnt > 0u ? cnt : 1u;
}
__device__ __forceinline__ void xcd_barrier(const XcdBarrier& b) {
    asm volatile("s_waitcnt vmcnt(0)" ::: "memory");
    __syncthreads();
    if (threadIdx.x == 0) {
        unsigned* bar = b.bar;
        __builtin_amdgcn_s_waitcnt(0);
        unsigned nloc = b.st[0], nx = b.st[1];
        if (nloc == 0u) { xcd_barrier_complete(bar, b.x, nloc, nx); b.st[0] = nloc; b.st[1] = nx; }
        const unsigned old = xb_add(&bar[XB_XSUB(b.x)], 1u);
        const unsigned gen = old / nloc;
        if (old + 1u == (gen + 1u) * nloc) {
            __builtin_amdgcn_fence(__ATOMIC_RELEASE, "agent");
            asm volatile("s_waitcnt vmcnt(0)" ::: "memory");
            const unsigned og = xb_add(&bar[XB_TOP], 1u);
            const unsigned tg = og / nx;
            if (og + 1u == (tg + 1u) * nx) xb_add(&bar[XB_TOPGEN], 1u);
            else XB_SPIN(xb_ld(&bar[XB_TOPGEN]) == tg, bar);
            __builtin_amdgcn_fence(__ATOMIC_ACQUIRE, "agent");
            xb_add(&bar[XB_XGEN(b.x)], 1u);
            asm volatile("s_waitcnt vmcnt(0)" ::: "memory");
        } else {
            XB_SPIN(xb_ld(&bar[XB_XGEN(b.x)]) == gen, bar);
            __builtin_amdgcn_fence(__ATOMIC_ACQUIRE, "agent");
            asm volatile("s_waitcnt vmcnt(0)" ::: "memory");
        }
    }
    __syncthreads();
}

struct Args { const float* in[28]; float* out; unsigned char* ws; int ph_lo, ph_hi; };
enum { I_XP = 0, I_XS, I_CK, I_CV, I_CLF, I_F1N, I_F1G, I_F1U, I_F1D, I_MIXN, I_F2N, I_F2G, I_F2U, I_F2D, I_WIN, I_LNG, I_LNB, I_WS, I_BS, I_WOUT, I_KVN, I_WK, I_WV, I_WF, I_BF, I_WQ, I_WO, I_FN };

__device__ __forceinline__ void tr_item(const float* W, int K, int N, const float* gain, float scale, bf16* WT, int mode, int row_off, LAS unsigned* scr, int item, int lane) {
    const int nblk = N / 128, grp = item >> 3, kb = 8 * (grp / nblk) + (item & 7), nb = grp % nblk, k0 = 64 * kb, n0 = 128 * nb;
    const int hl = lane >> 5, cl = lane & 31;
#pragma unroll 2
    for (int i0 = 0; i0 < 16; i0 += 8) {
        f32x4 ra[8], rb[8]; float ga[8], gb[8];
#pragma unroll
        for (int i = 0; i < 8; ++i) { const int kp = 2 * (i0 + i) + hl; const float* p = W + (size_t)(k0 + 2 * kp) * N + n0 + 4 * cl;
            ra[i] = __builtin_nontemporal_load((const GAS f32x4*)p); rb[i] = __builtin_nontemporal_load((const GAS f32x4*)(p + N));
            ga[i] = gain ? gain[k0 + 2 * kp] * scale : scale; gb[i] = gain ? gain[k0 + 2 * kp + 1] * scale : scale; }
#pragma unroll
        for (int i = 0; i < 8; ++i) { const int kp = 2 * (i0 + i) + hl;
            u32x4 w; w.x = cvt_pk_bf16(ra[i][0] * ga[i], rb[i][0] * gb[i]); w.y = cvt_pk_bf16(ra[i][1] * ga[i], rb[i][1] * gb[i]); w.z = cvt_pk_bf16(ra[i][2] * ga[i], rb[i][2] * gb[i]); w.w = cvt_pk_bf16(ra[i][3] * ga[i], rb[i][3] * gb[i]);
            *(LAS u32x4*)(scr + kp * 132 + 4 * cl) = w; }
    }
    LDS_WAIT(); asm volatile("" ::: "memory");
    const int c = lane & 7;
#pragma unroll 4
    for (int j = 0; j < 16; ++j) { const int n = (lane >> 3) + 8 * j; const LAS unsigned* sp = scr + (4 * c) * 132 + n;
        u32x4 o; o.x = sp[0]; o.y = sp[132]; o.z = sp[264]; o.w = sp[396];
        const int nn = n0 + n; const int drow = mode ? (256 * (nn >> 7) + row_off + (nn & 127)) : (row_off + nn);
        *(GAS u32x4*)(WT + (size_t)drow * K + k0 + 8 * c) = o; }
    LDS_WAIT(); asm volatile("" ::: "memory");
}
constexpr int IT_FFN = 1408, IT_WIN = 2048, IT_WOUT = 1024, IT_SQ = 512;
constexpr int IT_END_FFN = 24 * IT_FFN, IT_END_WIN = IT_END_FFN + 2 * IT_WIN, IT_END_WOUT = IT_END_WIN + 2 * IT_WOUT, IT_TOTAL = IT_END_WOUT + 6 * IT_SQ;
__device__ __forceinline__ void prologue(const Args& a, LAS unsigned char* lds, int vcu, int G, int wave, int lane) {
    unsigned char* ws = a.ws;
    LAS unsigned* scr = (LAS unsigned*)(lds + wave * 16896);
    const int gw = vcu * NWAVES + wave, NGW = G * NWAVES;
    for (int it_ = gw; it_ < IT_TOTAL; it_ += NGW) {
        const int it = IT_TOTAL - 1 - it_;
        if (it < IT_END_FFN) {
            const int j = it / IT_FFN, r = it - j * IT_FFN, hl = j / 3, t = j - hl * 3, l = hl >> 1, f = hl & 1;
            const float* nrm = a.in[f ? I_F2N : I_F1N] + (size_t)l * DM;
            if (t < 2) { const float* W = a.in[(f ? I_F2G : I_F1G) + t] + (size_t)l * DM * FF;
                tr_item(W, DM, FF, nrm, 1.0f, (bf16*)(ws + WS_WGU + (size_t)hl * SZ_WGU), 1, t * 128, scr, r, lane); }
            else { const float* W = a.in[f ? I_F2D : I_F1D] + (size_t)l * FF * DM;
                tr_item(W, FF, DM, nullptr, 1.0f, (bf16*)(ws + WS_WD + (size_t)hl * SZ_WD), 0, 0, scr, r, lane); }
        } else if (it < IT_END_WIN) {
            const int q = it - IT_END_FFN, l = q / IT_WIN, r = q - l * IT_WIN;
            tr_item(a.in[I_WIN] + (size_t)l * DM * 2 * DG, DM, 2 * DG, a.in[I_MIXN] + (size_t)l * DM, 1.0f, (bf16*)(ws + WS_WIN + (size_t)l * SZ_WIN), 0, 0, scr, r, lane);
        } else if (it < IT_END_WOUT) {
            const int q = it - IT_END_WIN, l = q / IT_WOUT, r = q - l * IT_WOUT;
            tr_item(a.in[I_WOUT] + (size_t)l * DG * DM, DG, DM, nullptr, 1.0f, (bf16*)(ws + WS_WOUT + (size_t)l * SZ_WOUT), 0, 0, scr, r, lane);
        } else {
            const int q = it - IT_END_WOUT, j = q / IT_SQ, r = q - j * IT_SQ;
            if (j < 2) tr_item(a.in[I_WK + j], DM, DM, a.in[I_KVN], 1.0f, (bf16*)(ws + WS_WKV), 0, j * DM, scr, r, lane);
            else if (j < 4) tr_item(a.in[I_WQ] + (size_t)(j - 2) * DM * DM, DM, DM, a.in[I_MIXN] + (size_t)(2 + j - 2) * DM, 0.08838834764831845f * LOG2E, (bf16*)(ws + WS_WQ + (size_t)(j - 2) * SZ_WQ), 0, 0, scr, r, lane);
            else tr_item(a.in[I_WO] + (size_t)(j - 4) * DM * DM, DM, DM, nullptr, 1.0f, (bf16*)(ws + WS_WO + (size_t)(j - 4) * SZ_WQ), 0, 0, scr, r, lane);
        }
    }
    bf16* XB = (bf16*)(ws + WS_XB); float* P = (float*)(ws + WS_P);
    { f32x4 xv[8]; int m = gw;
      if (m < M) { const float* src = m < SEQ ? a.in[I_XP] + (size_t)m * DM : a.in[I_XS] + (size_t)(m - SEQ) * DM;
#pragma unroll
          for (int j = 0; j < 8; ++j) xv[j] = *(const GAS f32x4*)(src + 256 * j + 4 * lane); }
      while (m < M) {
        const int mn = m + NGW; f32x4 xn[8];
#pragma unroll
        for (int j = 0; j < 8; ++j) xn[j] = xv[j];
        if (mn < M) { const float* src = mn < SEQ ? a.in[I_XP] + (size_t)mn * DM : a.in[I_XS] + (size_t)(mn - SEQ) * DM;
#pragma unroll
            for (int j = 0; j < 8; ++j) xn[j] = *(const GAS f32x4*)(src + 256 * j + 4 * lane); }
        float ss = 0.f;
#pragma unroll
        for (int j = 0; j < 8; ++j) { const f32x4 v = xv[j];
            u32x2 w; w.x = cvt_pk_bf16(v[0], v[1]); w.y = cvt_pk_bf16(v[2], v[3]); *(GAS u32x2*)(XB + (size_t)m * DM + 256 * j + 4 * lane) = w;
            ss += (v[0] * v[0] + v[1] * v[1]) + (v[2] * v[2] + v[3] * v[3]); }
        ss = wave_sum(ss);
        if (lane < 32) P[(size_t)m * 32 + lane] = lane == 0 ? ss : 0.f;
#pragma unroll
        for (int j = 0; j < 8; ++j) xv[j] = xn[j];
        m = mn;
      } }
    if (vcu < DEC_B) {
        const int tid = wave * 64 + lane, b = vcu, h = tid & 15, c = tid >> 4;
        const float* src = a.in[I_CLF] + ((size_t)b * PAST + (size_t)c * 64) * NH + h;
        LAS float* tots = (LAS float*)lds;
        float tot = 0.f;
#pragma unroll 1
        for (int s0 = 0; s0 < 64; s0 += 16) { float v[16];
#pragma unroll
            for (int i = 0; i < 16; ++i) v[i] = src[(size_t)(s0 + i) * NH];
#pragma unroll
            for (int i = 0; i < 16; ++i) tot += v[i]; }
        __syncthreads();
        tots[c * 16 + h] = tot;
        __syncthreads();
        float run = 0.f;
        for (int cc = 0; cc < c; ++cc) run += tots[cc * 16 + h];
        float* dst = (float*)(ws + WS_CKS) + (size_t)(b * NH + h) * CKS_STRIDE + c * 64;
#pragma unroll 1
        for (int s0 = 0; s0 < 64; s0 += 16) { float v[16];
#pragma unroll
            for (int i = 0; i < 16; ++i) v[i] = src[(size_t)(s0 + i) * NH];
#pragma unroll
            for (int i = 0; i < 16; ++i) { run += v[i]; dst[s0 + i] = -run * LOG2E; } }
        if (c == 31) ((float*)(ws + WS_CEND))[b * NH + h] = run;
    }
}

__device__ __forceinline__ void build_rtab(LAS float* rtab, const float* P, const pg8::HybridOrder& S, int tid) {
    asm volatile("" : "+v"(tid));
#pragma unroll 1
    for (int i = 0; i < 8; ++i) { pg8::Seg u; if (!S.seg(i, u)) break;
        const int row = u.pm * 256 + (tid >> 1); const f32x4* p = (const f32x4*)(P + (size_t)row * 32 + (tid & 1) * 16);
        const f32x4 a = p[0], b = p[1], c = p[2], d = p[3];
        float s = ((a[0] + a[1]) + (a[2] + a[3])) + ((b[0] + b[1]) + (b[2] + b[3])) + ((c[0] + c[1]) + (c[2] + c[3])) + ((d[0] + d[1]) + (d[2] + d[3]));
        s += xor_get<1>(s);
        if ((tid & 1) == 0) rtab[i * 256 + (tid >> 1)] = 1.0f / sqrtf(s * (1.0f / DM) + RMS_EPS); }
    __syncthreads();
}
__device__ __forceinline__ void build_srt(LAS float* srt, const float* P, const pg8::HybridOrder& S, int tid) {
    asm volatile("" : "+v"(tid));
    if (tid < 256) { const int i = tid >> 5, t = tid & 31; pg8::Seg u;
        if (S.seg(i, u)) { const int row = SEQ + 16 * (u.pm >> 1) + (t >> 1); const f32x4* p = (const f32x4*)(P + (size_t)row * 32 + (t & 1) * 16);
            const f32x4 a = p[0], b = p[1], c = p[2], d = p[3];
            float s = ((a[0] + a[1]) + (a[2] + a[3])) + ((b[0] + b[1]) + (b[2] + b[3])) + ((c[0] + c[1]) + (c[2] + c[3])) + ((d[0] + d[1]) + (d[2] + d[3]));
            s += xor_get<1>(s);
            if ((t & 1) == 0) srt[i * 16 + (t >> 1)] = 1.0f / sqrtf(s * (1.0f / DM) + RMS_EPS); } }
    __syncthreads();
}
template <class Epi>
__device__ __forceinline__ void fixup(const pg8::HybridOrder& S, const Epi& E, const unsigned char* slab, int tid) {
    if (!S.split) return;
    asm volatile("" : "+v"(tid));
    const int wid = __builtin_amdgcn_readfirstlane(tid >> 6), lane = tid & 63, wr = wid >> 2, wc = wid & 3, fr = lane & 15, fq = lane >> 4;
    const long W = (long)S.R * S.T;
    for (int item = S.c; item < S.R * 8; item += S.G) {
        const int r = item >> 3, ai = (item >> 2) & 1, m = item & 3;
        pg8::Unit u; u.sw = 0; S.decode(S.q * S.G + r, u.pm, u.pn);
        f32x4 v[2][2] = {{(f32x4){0.f, 0.f, 0.f, 0.f}, (f32x4){0.f, 0.f, 0.f, 0.f}}, {(f32x4){0.f, 0.f, 0.f, 0.f}, (f32x4){0.f, 0.f, 0.f, 0.f}}};
        const int ulo = r * S.T, uhi = ulo + S.T;
        int v0 = (int)(((long)ulo * S.G) / W) - 1; if (v0 < 0) v0 = 0;
#pragma unroll 1
        for (int vv = v0; vv < S.G; ++vv) {
            const int lov = (int)((long)vv * W / S.G), hiv = (int)((long)(vv + 1) * W / S.G);
            if (lov >= uhi) break;
            if (hiv <= ulo || hiv <= lov) continue;
            const int slot = r - lov / S.T;
            const unsigned char* base = slab + (size_t)(vv * 2 + slot) * 262144 + (size_t)tid * 16;
#pragma unroll
            for (int bj = 0; bj < 2; ++bj)
#pragma unroll
                for (int n = 0; n < 2; ++n) { const int j = ((ai * 2 + bj) * 4 + m) * 2 + n; v[bj][n] += *(const f32x4*)(base + (size_t)j * 8192); }
        }
        E.rows(v, u, ai, m, wr, wc, fr, fq);
    }
}

__device__ __forceinline__ f32x4 mini_tile(const bf16* A, const bf16* Bt, int K, LAS unsigned char* lds, int tid) {
    asm volatile("" : "+v"(tid));
    const int wid = __builtin_amdgcn_readfirstlane(tid >> 6), lane = tid & 63, r16 = lane & 15, kg = lane >> 4;
    const int kw = K >> 3, nb = kw >> 6;
    const bf16* ap = A + (size_t)r16 * K + wid * kw + 8 * kg;
    const bf16* bp = Bt + (size_t)r16 * K + wid * kw + 8 * kg;
    f32x4 acc[2][4];
#pragma unroll
    for (int m = 0; m < 2; ++m)
#pragma unroll
        for (int n = 0; n < 4; ++n) acc[m][n] = (f32x4){0.f, 0.f, 0.f, 0.f};
    bf16x8 a0[2][2], b0[4][2], a1[2][2], b1[4][2], a2[2][2], b2[4][2];
#define MT_LOAD(a_, b_, kk) do { _Pragma("unroll") for (int s_ = 0; s_ < 2; ++s_) { _Pragma("unroll") for (int m_ = 0; m_ < 2; ++m_) a_[m_][s_] = *(const bf16x8*)(ap + (size_t)m_ * 16 * K + (kk) + 32 * s_); \
        _Pragma("unroll") for (int n_ = 0; n_ < 4; ++n_) b_[n_][s_] = *(const bf16x8*)(bp + (size_t)n_ * 16 * K + (kk) + 32 * s_); } } while (0)
#define MT_MMA(a_, b_) do { _Pragma("unroll") for (int s_ = 0; s_ < 2; ++s_) _Pragma("unroll") for (int m_ = 0; m_ < 2; ++m_) _Pragma("unroll") for (int n_ = 0; n_ < 4; ++n_) \
        acc[m_][n_] = __builtin_amdgcn_mfma_f32_16x16x32_bf16(a_[m_][s_], b_[n_][s_], acc[m_][n_], 0, 0, 0); } while (0)
    MT_LOAD(a0, b0, 0);
    if (nb > 1) MT_LOAD(a1, b1, 64);
    for (int i = 0; i < nb; i += 3) {
        if (i + 2 < nb) MT_LOAD(a2, b2, (i + 2) * 64);
        MT_MMA(a0, b0);
        if (i + 3 < nb) MT_LOAD(a0, b0, (i + 3) * 64);
        if (i + 1 < nb) MT_MMA(a1, b1);
        if (i + 4 < nb) MT_LOAD(a1, b1, (i + 4) * 64);
        if (i + 2 < nb) MT_MMA(a2, b2);
    }
#undef MT_LOAD
#undef MT_MMA
    LAS float* part = (LAS float*)lds;
    __syncthreads();
#pragma unroll
    for (int m = 0; m < 2; ++m)
#pragma unroll
        for (int n = 0; n < 4; ++n)
#pragma unroll
            for (int rg = 0; rg < 4; ++rg) part[(wid * 32 + 16 * m + 4 * kg + rg) * 68 + 16 * n + r16] = acc[m][n][rg];
    __syncthreads();
    const int rloc = tid >> 4, c4 = (tid & 15) * 4;
    f32x4 v = (f32x4){0.f, 0.f, 0.f, 0.f};
#pragma unroll
    for (int w = 0; w < 8; ++w) v += *(const LAS f32x4*)(part + (w * 32 + rloc) * 68 + c4);
    __syncthreads();
    return v;
}
__device__ __forceinline__ void mini_resid(const bf16* A, const bf16* Bt, int K, bf16* XB, float* P, float alpha, LAS unsigned char* lds, int c, int tid) {
    const int rgp = c >> 5, cg = c & 31;
    const f32x4 v = mini_tile(A + (size_t)(SEQ + 32 * rgp) * K, Bt + (size_t)(64 * cg) * K, K, lds, tid);
    const int row = SEQ + 32 * rgp + (tid >> 4), col = 64 * cg + (tid & 15) * 4;
    bf16* xp = XB + (size_t)row * DM + col;
    const u32x2 xr = *(const u32x2*)xp;
    const f32x4 y = (f32x4){bf2f(xr.x & 0xffffu), bf2f(xr.x >> 16), bf2f(xr.y & 0xffffu), bf2f(xr.y >> 16)} + v * alpha;
    u32x2 w; w.x = cvt_pk_bf16(y[0], y[1]); w.y = cvt_pk_bf16(y[2], y[3]); *(u32x2*)xp = w;
    float ss = (y[0] * y[0] + y[1] * y[1]) + (y[2] * y[2] + y[3] * y[3]);
    ss += xor_get<1>(ss); ss += xor_get<2>(ss); ss += xor_get<4>(ss); ss += xor_get<8>(ss);
    if ((tid & 15) == 0) P[(size_t)row * 32 + cg] = ss;
}
__device__ __forceinline__ void mini_q(const bf16* A, const bf16* Bt, int K, bf16* Q, const float* P, LAS unsigned char* lds, int c, int tid) {
    const int rgp = c >> 5, cg = c & 31;
    const f32x4 v = mini_tile(A + (size_t)(SEQ + 32 * rgp) * K, Bt + (size_t)(64 * cg) * K, K, lds, tid);
    const int row = SEQ + 32 * rgp + (tid >> 4), col = 64 * cg + (tid & 15) * 4;
    const f32x4* p = (const f32x4*)(P + (size_t)row * 32); float s = 0.f;
#pragma unroll
    for (int i = 0; i < 8; ++i) { const f32x4 a = p[i]; s += (a[0] + a[1]) + (a[2] + a[3]); }
    const float r = 1.0f / sqrtf(s * (1.0f / DM) + RMS_EPS);
    u32x2 w; w.x = cvt_pk_bf16(v[0] * r, v[1] * r); w.y = cvt_pk_bf16(v[2] * r, v[3] * r); *(u32x2*)(Q + (size_t)row * DM + col) = w;
}

__device__ __forceinline__ int v_st(int k, int c) { const int kk = (k & ~0xC) | ((k & 4) << 1) | ((k & 8) >> 1); return ((kk >> 3) * 4 + (c >> 5)) * 512 + ((kk & 7) * 32 + (c & 31)) * 2; }
__device__ __forceinline__ int v_rd_base(int lane) { return ((lane & 3) << 3) | (((lane >> 2) & 3) << 6) | (((lane >> 4) & 1) << 5) | (((lane >> 5) & 1) << 8); }
constexpr int v_rd_off(int d0, int ks, int half) { return d0 * 512 + ks * 4096 + half * 2048; }
__device__ __forceinline__ int crow(int r, int hi) { return (r & 3) + 8 * (r >> 2) + 4 * hi; }
#define TRRD(dst, base, off) asm volatile("ds_read_b64_tr_b16 %0, %1 offset:%2" : "=&v"(dst) : "v"(base), "i"(off) : "memory")
template <int TILE_OFF>
__device__ __forceinline__ void mix_tile(f32x16* o, int vb0, bf16x8 pa0, bf16x8 pa1, bf16x8 pa2, bf16x8 pa3) {
#define MX_D0(d0) do { s16x4 l0, l1, l2, l3, h0, h1, h2, h3; constexpr int b_ = TILE_OFF + v_rd_off(d0, 0, 0); \
        TRRD(l0, vb0, b_); TRRD(h0, vb0, b_ + 2048); TRRD(l1, vb0, b_ + 4096); TRRD(h1, vb0, b_ + 6144); TRRD(l2, vb0, b_ + 8192); TRRD(h2, vb0, b_ + 10240); TRRD(l3, vb0, b_ + 12288); TRRD(h3, vb0, b_ + 14336); \
        asm volatile("s_waitcnt lgkmcnt(0)" ::: "memory"); __builtin_amdgcn_sched_barrier(0); \
        o[d0] = __builtin_amdgcn_mfma_f32_32x32x16_bf16((bf16x8){l0[0], l0[1], l0[2], l0[3], h0[0], h0[1], h0[2], h0[3]}, pa0, o[d0], 0, 0, 0); \
        o[d0] = __builtin_amdgcn_mfma_f32_32x32x16_bf16((bf16x8){l1[0], l1[1], l1[2], l1[3], h1[0], h1[1], h1[2], h1[3]}, pa1, o[d0], 0, 0, 0); \
        o[d0] = __builtin_amdgcn_mfma_f32_32x32x16_bf16((bf16x8){l2[0], l2[1], l2[2], l2[3], h2[0], h2[1], h2[2], h2[3]}, pa2, o[d0], 0, 0, 0); \
        o[d0] = __builtin_amdgcn_mfma_f32_32x32x16_bf16((bf16x8){l3[0], l3[1], l3[2], l3[3], h3[0], h3[1], h3[2], h3[3]}, pa3, o[d0], 0, 0, 0); } while (0)
    MX_D0(0); MX_D0(1); MX_D0(2); MX_D0(3);
#undef MX_D0
}
__device__ __forceinline__ void mix_unit(const Args& a, LAS unsigned char* lds, int l, int row0, int nrows, int g, float* gv_out  , int tid) {
    int z = 0; asm volatile("" : "+s"(z));
    unsigned char* ws = a.ws + z;
    const bf16* U = (const bf16*)(ws + WS_U); const bf16* V = (const bf16*)(ws + WS_V); bf16* Gt = (bf16*)(ws + WS_G); const f32x2* S1 = (const f32x2*)(ws + WS_S1);
    const float* w_s = a.in[I_WS + z] + ((size_t)l * 4 + g) * 128 * 128; const float* b_s = a.in[I_BS + z] + ((size_t)l * 4 + g) * 128;
    const float* lng = a.in[I_LNG + z] + (size_t)l * DG + g * 1024; const float* lnb = a.in[I_LNB + z] + (size_t)l * DG + g * 1024;
    asm volatile("" : "+v"(tid));
    const int wid = __builtin_amdgcn_readfirstlane(tid >> 6), lane = tid & 63, r32 = lane & 31, hi = lane >> 5;
    const int tb = wid & 3, ct = wid >> 2;
    LAS f32x2* stat = (LAS f32x2*)(lds + 65536); LAS float* lnp = (LAS float*)(lds + 66560);
    __syncthreads();
    { const int row = tid >> 2, qd = tid & 3; float s1 = 0.f, s2 = 0.f;
      if (row < nrows) { const f32x4* p = (const f32x4*)(S1 + (size_t)(row0 + row) * 64 + qd * 16);
#pragma unroll
          for (int i = 0; i < 8; ++i) { const f32x4 v = p[i]; s1 += v[0] + v[2]; s2 += v[1] + v[3]; } }
      s1 += xor_get<1>(s1); s1 += xor_get<2>(s1); s2 += xor_get<1>(s2); s2 += xor_get<2>(s2);
      if (qd == 0) { const float mean = s1 * (1.0f / DG); const float var = fmaxf(s2 * (1.0f / DG) - mean * mean, 0.f); stat[row] = (f32x2){mean, 1.0f / sqrtf(var + LN_EPS)}; } }
    const int t = 32 * tb + r32;
    bf16x8 pa[2][4];
#pragma unroll
    for (int st = 0; st < 2; ++st)
#pragma unroll
        for (int ks = 0; ks < 4; ++ks) { const int s0 = 64 * st + 16 * ks + 8 * hi; f32x4 w0 = (f32x4){0.f, 0.f, 0.f, 0.f}, w1 = w0;
            if (t < nrows && s0 <= t) { w0 = *(const f32x4*)(w_s + (size_t)t * 128 + s0); w1 = *(const f32x4*)(w_s + (size_t)t * 128 + s0 + 4); }
            float w[8] = {w0[0], w0[1], w0[2], w0[3], w1[0], w1[1], w1[2], w1[3]};
#pragma unroll
            for (int j = 0; j < 8; ++j) if (s0 + j > t || s0 + j >= nrows) w[j] = 0.f;
            u32x4 pk; pk.x = cvt_pk_bf16(w[0], w[1]); pk.y = cvt_pk_bf16(w[2], w[3]); pk.z = cvt_pk_bf16(w[4], w[5]); pk.w = cvt_pk_bf16(w[6], w[7]);
            pa[st][ks] = __builtin_bit_cast(bf16x8, pk); }
    const float bias = t < nrows ? b_s[t] : 0.f;
    const int nst = nrows > 64 ? 2 : 1;
    const int vb0 = (int)(uintptr_t)(lds) + v_rd_base(lane) + ct * 16384;
    const int sr = tid >> 4, sc = (tid & 15) * 8;
    u32x4 raw[2][2][2];
#define MIX_LOADV(slab_) do { const int cb_ = g * 1024 + (slab_) * 256; _Pragma("unroll") for (int st = 0; st < 2; ++st) _Pragma("unroll") for (int c2 = 0; c2 < 2; ++c2) _Pragma("unroll") for (int hh = 0; hh < 2; ++hh) { \
        const int s_ = 64 * st + 32 * hh + sr; raw[st][c2][hh] = (u32x4){0u, 0u, 0u, 0u}; if (st < nst && s_ < nrows) raw[st][c2][hh] = *(const u32x4*)(V + (size_t)(row0 + s_) * DG + cb_ + c2 * 128 + sc); } } while (0)
    MIX_LOADV(0);
    float lg_n = 0.f, lb_n = 0.f;
    if (tid < 256) { lg_n = lng[tid]; lb_n = lnb[tid]; }
    for (int slab = 0; slab < 4; ++slab) {
        const int cb = g * 1024 + slab * 256;
        if (tid < 256) { lnp[tid] = lg_n; lnp[256 + tid] = lb_n; }
        __syncthreads();
#pragma unroll
        for (int st = 0; st < 2; ++st)
#pragma unroll
            for (int c2 = 0; c2 < 2; ++c2)
#pragma unroll
                for (int hh = 0; hh < 2; ++hh) {
                    const int s = 64 * st + 32 * hh + sr; u32x4 pk = (u32x4){0u, 0u, 0u, 0u};
                    if (st < nst && s < nrows) {
                        const f32x2 ms = stat[s]; float vn[8];
                        const unsigned rw[4] = {raw[st][c2][hh].x, raw[st][c2][hh].y, raw[st][c2][hh].z, raw[st][c2][hh].w};
#pragma unroll
                        for (int j = 0; j < 4; ++j) { const int cc = c2 * 128 + sc + 2 * j;
                            vn[2 * j] = (bf2f(rw[j] & 0xffffu) - ms.x) * ms.y * lnp[cc] + lnp[256 + cc];
                            vn[2 * j + 1] = (bf2f(rw[j] >> 16) - ms.x) * ms.y * lnp[cc + 1] + lnp[256 + cc + 1]; }
                        pk.x = cvt_pk_bf16(vn[0], vn[1]); pk.y = cvt_pk_bf16(vn[2], vn[3]); pk.z = cvt_pk_bf16(vn[4], vn[5]); pk.w = cvt_pk_bf16(vn[6], vn[7]);
                        if (gv_out) { float* gp = gv_out + (size_t)s * DG + cb + c2 * 128 + sc; *(f32x4*)gp = (f32x4){vn[0], vn[1], vn[2], vn[3]}; *(f32x4*)(gp + 4) = (f32x4){vn[4], vn[5], vn[6], vn[7]}; }
                    }
                    if (st < nst) *(LAS u32x4*)(lds + (st * 2 + c2) * 16384 + v_st(32 * hh + sr, sc)) = pk;
                }
        if (slab + 1 < 4) MIX_LOADV(slab + 1);
        __syncthreads();
        f32x16 o[4];
#pragma unroll
        for (int d0 = 0; d0 < 4; ++d0) o[d0] = (f32x16){0.f, 0.f, 0.f, 0.f, 0.f, 0.f, 0.f, 0.f, 0.f, 0.f, 0.f, 0.f, 0.f, 0.f, 0.f, 0.f};
        if (32 * tb < nrows) {
            mix_tile<0>(o, vb0, pa[0][0], pa[0][1], pa[0][2], pa[0][3]);
            if (tb >= 2) mix_tile<32768>(o, vb0, pa[1][0], pa[1][1], pa[1][2], pa[1][3]);
        }
        { LAS unsigned char* wt = lds + 69632 + wid * 8704;
#pragma unroll
          for (int d0 = 0; d0 < 4; ++d0)
#pragma unroll
              for (int rq = 0; rq < 4; ++rq) { u32x2 w; w.x = cvt_pk_bf16(o[d0][4 * rq + 0] + bias, o[d0][4 * rq + 1] + bias); w.y = cvt_pk_bf16(o[d0][4 * rq + 2] + bias, o[d0][4 * rq + 3] + bias);
                  *(LAS u32x2*)(wt + r32 * 272 + (d0 * 32 + 8 * rq + 4 * hi) * 2) = w; }
          asm volatile("s_waitcnt lgkmcnt(0)" ::: "memory");
          const int rr = lane >> 4, ch = lane & 15;
          u32x4 uq[8];
#pragma unroll
          for (int it = 0; it < 8; ++it) { const int tt = 32 * tb + rr + 4 * it; uq[it] = (u32x4){0u, 0u, 0u, 0u};
              if (tt < nrows) uq[it] = *(const u32x4*)(U + (size_t)(row0 + tt) * DG + cb + ct * 128 + ch * 8); }
          if (slab + 1 < 4 && tid < 256) { lg_n = lng[(slab + 1) * 256 + tid]; lb_n = lnb[(slab + 1) * 256 + tid]; }
#pragma unroll
          for (int it = 0; it < 8; ++it) { const int rl = rr + 4 * it, tt = 32 * tb + rl;
              if (tt < nrows) { const size_t off = (size_t)(row0 + tt) * DG + cb + ct * 128 + ch * 8;
                  const u32x4 mx = *(const LAS u32x4*)(wt + rl * 272 + ch * 16); const u32x4 uu = uq[it];
                  const unsigned mw[4] = {mx.x, mx.y, mx.z, mx.w}, uw[4] = {uu.x, uu.y, uu.z, uu.w}; u32x4 gw; unsigned gg[4];
#pragma unroll
                  for (int j = 0; j < 4; ++j) gg[j] = cvt_pk_bf16(bf2f(uw[j] & 0xffffu) * bf2f(mw[j] & 0xffffu), bf2f(uw[j] >> 16) * bf2f(mw[j] >> 16));
                  gw.x = gg[0]; gw.y = gg[1]; gw.z = gg[2]; gw.w = gg[3]; *(u32x4*)(Gt + off) = gw; } }
          asm volatile("s_waitcnt lgkmcnt(0)" ::: "memory"); }
    }
}

#undef MIX_LOADV
namespace fa {
constexpr int D = 128, PITCH = DM, NW = 8, QBLK = 32, KVBLK = 64, QB = NW * QBLK;
constexpr int SHM_V = KVBLK * D * 2, SHM_K = KVBLK * D * 2;
constexpr int OFF_WS = 2 * SHM_V + 2 * SHM_K, OFF_KX = OFF_WS + NW * 64 * 4, LDS_NEED = OFF_KX + 2 * 256;
constexpr float THR = 8.f;
#define KSWZ(row, colB) ((row) * 256 + ((colB) ^ (((row) & 7) << 4)))
#define SBAR() __builtin_amdgcn_sched_barrier(0)
__device__ __forceinline__ void mask_tile(f32x16& p0, f32x16& p1, int dq, unsigned W) {
    const float NEG = -__builtin_inff();
#pragma unroll
    for (int r = 0; r < 16; ++r) {
        const int c = (r & 3) + 8 * (r >> 2);
        if ((unsigned)(dq - c) >= W) p0[r] = NEG;
        if ((unsigned)(dq - c - 32) >= W) p1[r] = NEG;
    }
}
__device__ __forceinline__ void partialSM(f32x16& p0, f32x16& p1, float& m_reg, float& mn, float& alpha) {
    float pmax = p0[0]; for (int r = 1; r < 16; ++r) pmax = fmaxf(pmax, p0[r]); for (int r = 0; r < 16; ++r) pmax = fmaxf(pmax, p1[r]);
    { auto rr = __builtin_amdgcn_permlane32_swap(__float_as_uint(pmax), __float_as_uint(pmax), false, false);
      pmax = fmaxf(__uint_as_float(rr[0]), __uint_as_float(rr[1])); }
    if (__builtin_expect(__all((pmax - m_reg) * LN2 <= THR), 1)) { mn = m_reg; alpha = 1.f; }
    else { mn = fmaxf(m_reg, pmax); alpha = __builtin_amdgcn_exp2f(m_reg - mn); m_reg = mn; }
    for (int r = 0; r < 16; ++r) p0[r] = p0[r] - mn; for (int r = 0; r < 16; ++r) p1[r] = p1[r] - mn;
    for (int r = 0; r < 16; ++r) p0[r] = __builtin_amdgcn_exp2f(p0[r]);
}
__device__ __forceinline__ void finishSM(f32x16& p0, f32x16& p1, float alpha, float& l_reg, bf16x8& pa0, bf16x8& pa1, bf16x8& pa2, bf16x8& pa3) {
    for (int r = 0; r < 16; ++r) p1[r] = __builtin_amdgcn_exp2f(p1[r]);
    float ps = 0; for (int r = 0; r < 16; ++r) ps += p0[r]; for (int r = 0; r < 16; ++r) ps += p1[r];
    { auto rr = __builtin_amdgcn_permlane32_swap(__float_as_uint(ps), __float_as_uint(ps), false, false);
      ps = __uint_as_float(rr[0]) + __uint_as_float(rr[1]); }
    l_reg = l_reg * alpha + ps;
#define PK4(P, B_, OUT) do { unsigned a0 = cvt_pk_bf16(P[B_+0], P[B_+1]), a1 = cvt_pk_bf16(P[B_+2], P[B_+3]);                          \
        unsigned b0 = cvt_pk_bf16(P[B_+4], P[B_+5]), b1 = cvt_pk_bf16(P[B_+6], P[B_+7]);                                             \
        auto r0 = __builtin_amdgcn_permlane32_swap(a0, b0, false, false); auto r1 = __builtin_amdgcn_permlane32_swap(a1, b1, false, false); \
        u32x4 w = {r0[0], r1[0], r0[1], r1[1]}; OUT = *reinterpret_cast<bf16x8*>(&w); } while (0)
    PK4(p0, 0, pa0); PK4(p0, 8, pa1); PK4(p1, 0, pa2); PK4(p1, 8, pa3);
#undef PK4
}
template <int KB>
__device__ __forceinline__ void qkt(f32x16& p0, f32x16& p1, const char* K_lds, int r32, int hi, const bf16x8* qr) {
    p0 = f32x16{}; p1 = f32x16{};
    const char* kb[4];
#pragma unroll
    for (int dd = 0; dd < 4; ++dd) kb[dd] = K_lds + KB * SHM_K + KSWZ(r32, (dd * 16 + hi * 8) * 2);
#pragma unroll
    for (int d0 = 0; d0 < 8; ++d0) { const char* a = kb[d0 & 3] + (d0 >> 2) * 128;
        bf16x8 b0 = *reinterpret_cast<const bf16x8*>(a);
        bf16x8 b1 = *reinterpret_cast<const bf16x8*>(a + 32 * 256);
        p0 = __builtin_amdgcn_mfma_f32_32x32x16_bf16(b0, qr[d0], p0, 0, 0, 0);
        p1 = __builtin_amdgcn_mfma_f32_32x32x16_bf16(b1, qr[d0], p1, 0, 0, 0); }
}
template <int VB>
__device__ __forceinline__ void pv_tile(f32x16* o, int vb0, bf16x8 pa0, bf16x8 pa1, bf16x8 pa2, bf16x8 pa3) {
#define PV_D0(d0) do { s16x4 l0, l1, l2, l3, h0, h1, h2, h3; constexpr int b_ = VB * SHM_V + v_rd_off(d0, 0, 0); \
        TRRD(l0, vb0, b_); TRRD(h0, vb0, b_ + 2048); TRRD(l1, vb0, b_ + 4096); TRRD(h1, vb0, b_ + 6144); TRRD(l2, vb0, b_ + 8192); TRRD(h2, vb0, b_ + 10240); TRRD(l3, vb0, b_ + 12288); TRRD(h3, vb0, b_ + 14336); \
        asm volatile("s_waitcnt lgkmcnt(0)" ::: "memory"); SBAR(); \
        o[d0] = __builtin_amdgcn_mfma_f32_32x32x16_bf16(pa0, (bf16x8){l0[0], l0[1], l0[2], l0[3], h0[0], h0[1], h0[2], h0[3]}, o[d0], 0, 0, 0);   \
        o[d0] = __builtin_amdgcn_mfma_f32_32x32x16_bf16(pa1, (bf16x8){l1[0], l1[1], l1[2], l1[3], h1[0], h1[1], h1[2], h1[3]}, o[d0], 0, 0, 0);   \
        o[d0] = __builtin_amdgcn_mfma_f32_32x32x16_bf16(pa2, (bf16x8){l2[0], l2[1], l2[2], l2[3], h2[0], h2[1], h2[2], h2[3]}, o[d0], 0, 0, 0);   \
        o[d0] = __builtin_amdgcn_mfma_f32_32x32x16_bf16(pa3, (bf16x8){l3[0], l3[1], l3[2], l3[3], h3[0], h3[1], h3[2], h3[3]}, o[d0], 0, 0, 0); } while (0)
    PV_D0(0); PV_D0(1); PV_D0(2); PV_D0(3);
#undef PV_D0
}
struct BlockRef { const bf16* Q; const bf16* K; const bf16* V; const float* KX; bf16* O; int P0; };
struct Seam { bf16x8 qr[8]; bf16x8 st_v0, st_v1, st_k0, st_k1; float st_kx; };
#define ROWP(p, k0, rr) ((p) + (size_t)((k0) + (rr)) * PITCH + sc)
#define VMW() asm volatile("s_waitcnt vmcnt(0)" ::: "memory")
#define VMWN(n) asm volatile("s_waitcnt vmcnt(%0)" :: "i"(n) : "memory")
#define SLOAD_H(Kp, Vp, KXp, k0) do { S.st_v0 = *(const bf16x8*)ROWP(Vp, k0, sr); S.st_v1 = *(const bf16x8*)ROWP(Vp, k0, 32 + sr);              \
                         S.st_k0 = *(const bf16x8*)ROWP(Kp, k0, sr); S.st_k1 = *(const bf16x8*)ROWP(Kp, k0, 32 + sr); \
                         S.st_kx = (KXp)[(k0) + (tid & 63)]; } while (0)
#define SWRITE_HK(bf) do { *(bf16x8*)(K_lds + (bf) * SHM_K + kws) = S.st_k0; *(bf16x8*)(K_lds + (bf) * SHM_K + kws + 32 * 256) = S.st_k1; \
                           if (tid < 64) *(float*)(KX_lds + (bf) * 256 + tid * 4) = S.st_kx; } while (0)
#define SWRITE_HV(bf) do { *(bf16x8*)(V_lds + (bf) * SHM_V + vst0) = S.st_v0; *(bf16x8*)(V_lds + (bf) * SHM_V + vst1) = S.st_v1; } while (0)
#define SWRITE_H(bf) do { SWRITE_HV(bf); SWRITE_HK(bf); } while (0)
__device__ __forceinline__ int prime(const BlockRef& cur, float kn2, char* lds, Seam& S, int wave_) {
    unsigned m_ = ~0u; asm volatile("" : "+s"(m_)); const int tid_ = wave_ * 64 + (int)__builtin_amdgcn_mbcnt_hi(m_, __builtin_amdgcn_mbcnt_lo(m_, 0u));
    const int tid = tid_, wid = __builtin_amdgcn_readfirstlane(tid >> 6), lane = tid & 63, r32 = lane & 31, hi = lane >> 5;
    const int sr = tid >> 4, sc = (tid & 15) * 8, kws = KSWZ(sr, sc * 2); char* K_lds = lds + 2 * SHM_V; char* KX_lds = lds + OFF_KX;
    for (int d0 = 0; d0 < 8; ++d0) S.qr[d0] = *(const bf16x8*)(cur.Q + (size_t)(wid * QBLK + r32) * PITCH + d0 * 16 + hi * 8);
    float qs = 0.f;
#pragma unroll
    for (int d0 = 0; d0 < 8; ++d0)
#pragma unroll
        for (int e = 0; e < 8; ++e) { const float v = bf2f((unsigned)(unsigned short)S.qr[d0][e]); qs += v * v; }
    qs = sum32(qs);
    qs = fmaxf(qs, xor_get<1>(qs)); qs = fmaxf(qs, xor_get<2>(qs)); qs = fmaxf(qs, xor_get<4>(qs)); qs = fmaxf(qs, xor_get<8>(qs)); qs = fmaxf(qs, xor_get<16>(qs));
    float* red = (float*)(lds + OFF_WS);
    if (lane == 0) red[wid] = qs;
    __syncthreads();
    float qn2 = red[0];
#pragma unroll
    for (int w = 1; w < 8; ++w) qn2 = fmaxf(qn2, red[w]);
    const float thr = cur.KX[cur.P0] - (2.02f * sqrtf(qn2 * kn2) + 170.f);
    const int nbefore = cur.P0 / KVBLK;
    const bool f0 = lane < nbefore && cur.KX[KVBLK * lane + KVBLK - 1] <= thr, f1 = lane + 64 < nbefore && cur.KX[KVBLK * (lane + 64) + KVBLK - 1] <= thr;
    const int j_lo = __builtin_amdgcn_readfirstlane(__popcll(__ballot(f0)) + __popcll(__ballot(f1)));
    SLOAD_H(cur.K, cur.V, cur.KX, j_lo * KVBLK); VMW(); SWRITE_HK(0);
    __syncthreads();
    return j_lo;
}
__device__ __forceinline__ void block(const BlockRef& cur, const int j_lo, char* lds, Seam& S, int wave_) {
    unsigned m_ = ~0u; asm volatile("" : "+s"(m_)); const int tid_ = wave_ * 64 + (int)__builtin_amdgcn_mbcnt_hi(m_, __builtin_amdgcn_mbcnt_lo(m_, 0u));
    const int tid = tid_, wid = __builtin_amdgcn_readfirstlane(tid >> 6), lane = tid & 63, r32 = lane & 31, hi = lane >> 5;
    const int NT = (cur.P0 + QB - 1) / KVBLK + 1 - j_lo;
    const int qlo = cur.P0 + wid * QBLK, qm = qlo + r32 - 4 * hi;
    char* V_lds = lds; char* K_lds = lds + 2 * SHM_V; char* KX_lds = lds + OFF_KX;
    float* wsp = (float*)(lds + OFF_WS) + wid * 64; float* li_l = wsp, * al_l = wsp + 32;
    float m_reg = -1e30f, l_reg = 0; f32x16 o[4] = {};
    const int sr = tid >> 4, sc = (tid & 15) * 8, vst0 = v_st(sr, sc), vst1 = v_st(32 + sr, sc), kws = KSWZ(sr, sc * 2);
    const int vb0 = (int)(uintptr_t)V_lds + v_rd_base(lane);
    const bf16* Kh = cur.K; const bf16* Vh = cur.V; const float* KXh = cur.KX;
    const unsigned W = 0x40000000u;
    const char* kxb = KX_lds + hi * 16;
#define RESC(a) do { if (__any((a) < 1.f)) { if (hi == 0) al_l[r32] = (a); asm volatile("s_waitcnt lgkmcnt(0)" ::: "memory");              \
                     for (int d_ = 0; d_ < 4; ++d_) for (int r = 0; r < 16; ++r) o[d_][r] *= al_l[crow(r, hi)]; } } while (0)
#define KBASE(t) ((j_lo + (t)) * KVBLK)
#define BIAS(P0_, P1_, kb_i) do { _Pragma("unroll") for (int rq = 0; rq < 4; ++rq) { \
        const f32x4 c0_ = *reinterpret_cast<const f32x4*>(kxb + (kb_i) * 256 + rq * 32), c1_ = *reinterpret_cast<const f32x4*>(kxb + (kb_i) * 256 + 128 + rq * 32); \
        P0_[4 * rq] += c0_[0]; P0_[4 * rq + 1] += c0_[1]; P0_[4 * rq + 2] += c0_[2]; P0_[4 * rq + 3] += c0_[3]; P1_[4 * rq] += c1_[0]; P1_[4 * rq + 1] += c1_[1]; P1_[4 * rq + 2] += c1_[2]; P1_[4 * rq + 3] += c1_[3]; SBAR(); } } while (0)
#define MASKT(P0_, P1_, t) do { const int kb_ = KBASE(t); BIAS(P0_, P1_, (t) & 1); if (kb_ + KVBLK - 1 > qlo) mask_tile(P0_, P1_, qm - kb_, W); } while (0)
    f32x16 pA0, pA1, pB0, pB1; float mnA, mnB, alA, alB; bf16x8 pa0, pa1, pa2, pa3;
    SWRITE_HV(0); SBAR();
    if (NT > 1) { SLOAD_H(Kh, Vh, KXh, KBASE(1)); }
    SBAR(); qkt<0>(pA0, pA1, K_lds, r32, hi, S.qr);
    MASKT(pA0, pA1, 0); partialSM(pA0, pA1, m_reg, mnA, alA);
    if (NT > 1) { VMW(); SWRITE_H(1); }
    __syncthreads();
#define HALF_STEP(PX0, PX1, mnX, alX, PY0, PY1, alY, t, KB, VB, SB) do {                                                      \
        SBAR(); qkt<KB>(PX0, PX1, K_lds, r32, hi, S.qr);                                             \
        finishSM(PY0, PY1, alY, l_reg, pa0, pa1, pa2, pa3); SBAR();                                                           \
        if ((t) + 1 < NT) { SLOAD_H(Kh, Vh, KXh, KBASE((t) + 1)); SBAR(); }                                               \
        pv_tile<VB>(o, vb0, pa0, pa1, pa2, pa3); MASKT(PX0, PX1, (t)); partialSM(PX0, PX1, m_reg, mnX, alX);                                        \
        __syncthreads();                                                                                                      \
        if ((t) + 1 < NT) { VMW(); SWRITE_H(SB); }                                                                          \
        RESC(alX); __syncthreads(); } while (0)
    for (int t = 1; t + 1 < NT; t += 2) {
        HALF_STEP(pB0, pB1, mnB, alB, pA0, pA1, alA, t, 1, 0, 0);
        HALF_STEP(pA0, pA1, mnA, alA, pB0, pB1, alB, t + 1, 0, 1, 1);
    }
    const bool even = (NT & 1) == 0;
    if (even) { SBAR(); qkt<1>(pB0, pB1, K_lds, r32, hi, S.qr); SBAR(); }
    finishSM(pA0, pA1, alA, l_reg, pa0, pa1, pa2, pa3); SBAR();
    pv_tile<0>(o, vb0, pa0, pa1, pa2, pa3);
    if (even) { MASKT(pB0, pB1, NT - 1); partialSM(pB0, pB1, m_reg, mnB, alB); __syncthreads(); RESC(alB);
        finishSM(pB0, pB1, alB, l_reg, pa0, pa1, pa2, pa3); SBAR(); pv_tile<1>(o, vb0, pa0, pa1, pa2, pa3); }
    SBAR();
    if (hi == 0) li_l[r32] = l_reg; asm volatile("s_waitcnt lgkmcnt(0)" ::: "memory");
    float rli[16];
#pragma unroll
    for (int r = 0; r < 16; ++r) rli[r] = __builtin_amdgcn_rcpf(li_l[crow(r, hi)]);
    bf16* Ow = cur.O + (size_t)(wid * QBLK) * PITCH;
#pragma unroll
    for (int r = 0; r < 16; ++r) { const int orow = crow(r, hi);
#pragma unroll
        for (int d0 = 0; d0 < 4; ++d0) { const float v = o[d0][r] * rli[r];
            const float vn = xor_get<1>(v);
            if ((r32 & 1) == 0) *(unsigned*)(Ow + (size_t)orow * PITCH + d0 * 32 + r32) = cvt_pk_bf16(v, vn); } }
    __syncthreads();
#undef RESC
#undef KBASE
#undef MASKT
#undef BIAS
#undef HALF_STEP
}
#undef ROWP
#undef VMW
#undef VMWN
#undef SLOAD_H
#undef SWRITE_HK
#undef SWRITE_HV
#undef SWRITE_H
}

__device__ __forceinline__ void attn_sample(const Args& a, LAS unsigned char* lds, int item, int tid) {
    int z = 0; asm volatile("" : "+s"(z));
    unsigned char* ws = a.ws + z;
    const int b = item >> 4, h = item & 15;
    asm volatile("" : "+v"(tid));
    const int wid = __builtin_amdgcn_readfirstlane(tid >> 6), lane = tid & 63, qi = lane & 15, g = lane >> 4;
    const bf16* QB_ = (const bf16*)(ws + WS_QB); const bf16* KBn = (const bf16*)(ws + WS_KB); const bf16* VBn = (const bf16*)(ws + WS_VB); bf16* OB_ = (bf16*)(ws + WS_OB);
    const float* ck = (const float*)(ws + WS_CKS) + (size_t)item * CKS_STRIDE;
    const float* Kc = a.in[I_CK + z] + ((size_t)b * PAST * NH + h) * HD; const float* Vc = a.in[I_CV + z] + ((size_t)b * PAST * NH + h) * HD;
    const size_t srow0 = (size_t)(SEQ + DEC_T * b);
    LAS unsigned char* vt = lds + wid * 9216;
    LAS float* comb = (LAS float*)(lds + 73728);
    LAS float* opart = (LAS float*)(lds);
    __syncthreads();
    bf16x8 qf[4];
#pragma unroll
    for (int ks = 0; ks < 4; ++ks) qf[ks] = *(const bf16x8*)(QB_ + (srow0 + qi) * DM + h * HD + 32 * ks + 8 * g);
    float m_run = -1e30f, l_run = 0.f; f32x4 o[8];
#pragma unroll
    for (int dt = 0; dt < 8; ++dt) o[dt] = (f32x4){0.f, 0.f, 0.f, 0.f};
    const int vkey = lane >> 4, vch = lane & 15;
    const int trq = (lane & 15) >> 2, trp = lane & 3;
    const int tr_base = (int)(uintptr_t)vt + (4 * g + trq) * 288 + trp * 8;
    const int nsteps = wid == 0 ? 9 : 8;
    for (int stp = 0; stp < nsteps; ++stp) {
        const bool newk = stp == 8;
        const int s0 = wid * 256 + stp * 32;
        f32x4 sT[2];
        u32x4 vpk[8];
        if (!newk) {
            f32x4 kr[2][4][2];
#pragma unroll
            for (int aa = 0; aa < 2; ++aa)
#pragma unroll
                for (int ks = 0; ks < 4; ++ks) { const float* kp = Kc + (size_t)(s0 + 16 * aa + qi) * DM + 32 * ks + 8 * g; kr[aa][ks][0] = __builtin_nontemporal_load((const f32x4*)kp); kr[aa][ks][1] = __builtin_nontemporal_load((const f32x4*)(kp + 4)); }
            f32x4 vr[8][2];
#pragma unroll
            for (int it = 0; it < 8; ++it) { const float* vp = Vc + (size_t)(s0 + vkey + 4 * it) * DM + 8 * vch; vr[it][0] = __builtin_nontemporal_load((const f32x4*)vp); vr[it][1] = __builtin_nontemporal_load((const f32x4*)(vp + 4)); }
            const f32x4 c0 = *(const f32x4*)(ck + s0 + 4 * g), c1 = *(const f32x4*)(ck + s0 + 16 + 4 * g);
#pragma unroll
            for (int aa = 0; aa < 2; ++aa) { f32x4 acc = aa ? c1 : c0;
#pragma unroll
                for (int ks = 0; ks < 4; ++ks) { u32x4 pk; pk.x = cvt_pk_bf16(kr[aa][ks][0][0], kr[aa][ks][0][1]); pk.y = cvt_pk_bf16(kr[aa][ks][0][2], kr[aa][ks][0][3]); pk.z = cvt_pk_bf16(kr[aa][ks][1][0], kr[aa][ks][1][1]); pk.w = cvt_pk_bf16(kr[aa][ks][1][2], kr[aa][ks][1][3]);
                    acc = __builtin_amdgcn_mfma_f32_16x16x32_bf16(__builtin_bit_cast(bf16x8, pk), qf[ks], acc, 0, 0, 0); }
                sT[aa] = acc; }
#pragma unroll
            for (int it = 0; it < 8; ++it) { vpk[it].x = cvt_pk_bf16(vr[it][0][0], vr[it][0][1]); vpk[it].y = cvt_pk_bf16(vr[it][0][2], vr[it][0][3]); vpk[it].z = cvt_pk_bf16(vr[it][1][0], vr[it][1][1]); vpk[it].w = cvt_pk_bf16(vr[it][1][2], vr[it][1][3]); }
        } else {
            const f32x4 c0 = *(const f32x4*)(ck + PAST + 4 * g);
            f32x4 acc = c0;
#pragma unroll
            for (int ks = 0; ks < 4; ++ks) { const bf16x8 kf = *(const bf16x8*)(KBn + (srow0 + qi) * DM + h * HD + 32 * ks + 8 * g);
                acc = __builtin_amdgcn_mfma_f32_16x16x32_bf16(kf, qf[ks], acc, 0, 0, 0); }
            const float NEG = -__builtin_inff();
#pragma unroll
            for (int j = 0; j < 4; ++j) if (4 * g + j > qi) acc[j] = NEG;
            sT[0] = acc; sT[1] = (f32x4){NEG, NEG, NEG, NEG};
#pragma unroll
            for (int it = 0; it < 8; ++it) { vpk[it] = (u32x4){0u, 0u, 0u, 0u};
                if (it < 4) vpk[it] = *(const u32x4*)(VBn + (srow0 + vkey + 4 * it) * DM + h * HD + 8 * vch); }
        }
        float tmax = fmaxf(fmaxf(fmaxf(sT[0][0], sT[0][1]), fmaxf(sT[0][2], sT[0][3])), fmaxf(fmaxf(sT[1][0], sT[1][1]), fmaxf(sT[1][2], sT[1][3])));
        tmax = fmaxf(tmax, xor_get<16>(tmax)); tmax = max32(tmax);
        const float mn = fmaxf(m_run, tmax); const float alpha = __builtin_amdgcn_exp2f(m_run - mn); m_run = mn;
        float p[8]; float ps = 0.f;
#pragma unroll
        for (int j = 0; j < 4; ++j) { p[j] = __builtin_amdgcn_exp2f(sT[0][j] - mn); p[4 + j] = __builtin_amdgcn_exp2f(sT[1][j] - mn); ps += p[j] + p[4 + j]; }
        ps += xor_get<16>(ps); ps = sum32(ps);
        l_run = l_run * alpha + ps;
        u32x4 ppk; ppk.x = cvt_pk_bf16(p[0], p[1]); ppk.y = cvt_pk_bf16(p[2], p[3]); ppk.z = cvt_pk_bf16(p[4], p[5]); ppk.w = cvt_pk_bf16(p[6], p[7]);
        const bf16x8 pfrag = __builtin_bit_cast(bf16x8, ppk);
#pragma unroll
        for (int it = 0; it < 8; ++it) *(LAS u32x4*)(vt + (vkey + 4 * it) * 288 + vch * 16) = vpk[it];
        asm volatile("s_waitcnt lgkmcnt(0)" ::: "memory");
#define SA_PV(dt) do { s16x4 lo, hi4; TRRD(lo, tr_base, (dt) * 32); TRRD(hi4, tr_base, (dt) * 32 + 16 * 288); \
            asm volatile("s_waitcnt lgkmcnt(0)" ::: "memory"); __builtin_amdgcn_sched_barrier(0); \
            const f32x4 od = o[dt] * alpha; \
            o[dt] = __builtin_amdgcn_mfma_f32_16x16x32_bf16((bf16x8){lo[0], lo[1], lo[2], lo[3], hi4[0], hi4[1], hi4[2], hi4[3]}, pfrag, od, 0, 0, 0); } while (0)
        SA_PV(0); SA_PV(1); SA_PV(2); SA_PV(3); SA_PV(4); SA_PV(5); SA_PV(6); SA_PV(7);
#undef SA_PV
        asm volatile("s_waitcnt lgkmcnt(0)" ::: "memory");
    }
    __syncthreads();
    if (g == 0) { comb[wid * 32 + qi] = m_run; comb[wid * 32 + 16 + qi] = l_run; }
#pragma unroll
    for (int dt = 0; dt < 8; ++dt) *(LAS f32x4*)(opart + ((size_t)(wid * 16 + qi) * 128 + 16 * dt + 4 * g)) = o[dt];
    __syncthreads();
    { const int q = tid >> 5, d4 = (tid & 31) * 4;
      float mm = -1e30f;
#pragma unroll
      for (int w = 0; w < 8; ++w) mm = fmaxf(mm, comb[w * 32 + q]);
      float lt = 0.f; f32x4 acc = (f32x4){0.f, 0.f, 0.f, 0.f};
#pragma unroll
      for (int w = 0; w < 8; ++w) { const float sc = __builtin_amdgcn_exp2f(comb[w * 32 + q] - mm); lt += comb[w * 32 + 16 + q] * sc; acc += *(const LAS f32x4*)(opart + ((size_t)(w * 16 + q) * 128 + d4)) * sc; }
      const float inv = 1.0f / lt;
      u32x2 w2; w2.x = cvt_pk_bf16(acc[0] * inv, acc[1] * inv); w2.y = cvt_pk_bf16(acc[2] * inv, acc[3] * inv);
      *(u32x2*)(OB_ + (srow0 + q) * DM + h * HD + d4) = w2; }
    __syncthreads();
}

__device__ __forceinline__ void logf_task(const Args& a, const LAS float* wfg, int rowbase, int nvalid, int lane) {
    int z = 0; asm volatile("" : "+s"(z)); asm volatile("" : "+v"(lane));
    const bf16* X = (const bf16*)(a.ws + z + WS_XB);
    float acc[64]; float ssq[4];
#pragma unroll
    for (int i = 0; i < 64; ++i) acc[i] = 0.f;
#pragma unroll
    for (int r = 0; r < 4; ++r) ssq[r] = 0.f;
    u32x4 xr[4][4];
#pragma unroll
    for (int r = 0; r < 4; ++r) { const int rr = r < nvalid ? r : 0;
#pragma unroll
        for (int i = 0; i < 4; ++i) xr[r][i] = *(const u32x4*)(X + (size_t)(rowbase + rr) * DM + 512 * i + 8 * lane); }
#pragma unroll
    for (int i = 0; i < 4; ++i)
#pragma unroll
        for (int e = 0; e < 8; ++e) { float xv[4];
#pragma unroll
            for (int r = 0; r < 4; ++r) { const unsigned w2 = e < 2 ? xr[r][i].x : (e < 4 ? xr[r][i].y : (e < 6 ? xr[r][i].z : xr[r][i].w)); xv[r] = bf2f((e & 1) ? (w2 >> 16) : (w2 & 0xffffu)); ssq[r] += xv[r] * xv[r]; }
#pragma unroll
            for (int h = 0; h < 16; ++h) { const float w = wfg[h * DM + 512 * i + 64 * e + lane];
#pragma unroll
                for (int r = 0; r < 4; ++r) acc[r * 16 + h] += xv[r] * w; }
        }
#pragma unroll
    for (int r = 0; r < 4; ++r) ssq[r] = wave_sum(ssq[r]);
#define RS_STEP(o, n) do { const bool up = (lane & (o)) != 0; _Pragma("unroll") for (int i = 0; i < (n) / 2; ++i) { const float send = up ? acc[i] : acc[i + (n) / 2]; const float keep = up ? acc[i + (n) / 2] : acc[i]; acc[i] = keep + lane_get(send, lane ^ (o)); } } while (0)
    RS_STEP(32, 64); RS_STEP(16, 32); RS_STEP(8, 16); RS_STEP(4, 8); RS_STEP(2, 4); RS_STEP(1, 2);
#undef RS_STEP
    const int r = lane >> 4, h = lane & 15;
    const float ss = r == 0 ? ssq[0] : (r == 1 ? ssq[1] : (r == 2 ? ssq[2] : ssq[3]));
    const float rs = 1.0f / sqrtf(ss * (1.0f / DM) + RMS_EPS);
    const float zz = acc[0] * rs + a.in[I_BF + z][h];
    const float lf = fminf(zz, 0.f) - log1pf(__expf(-fabsf(zz)));
    if (r < nvalid) { const int row = rowbase + r;
        ((float*)(a.ws + z + WS_LOGF))[(size_t)row * NH + h] = lf;
        if (row < SEQ) a.out[O_LP + (size_t)row * NH + h] = lf; else a.out[O_LS + (size_t)(row - SEQ) * NH + h] = lf; }
}
__device__ __forceinline__ void logf_phase(const Args& a, LAS unsigned char* lds, int wgid, int tid) {
    LAS float* wfg = (LAS float*)lds;
    int z = 0; asm volatile("" : "+s"(z)); asm volatile("" : "+v"(tid));
    const int wave = __builtin_amdgcn_readfirstlane(tid >> 6), lane = tid & 63;
    __syncthreads();
    { const float* wf = a.in[I_WF + z]; const float* kvn = a.in[I_KVN + z]; f32x4 wv[4][4]; float gk[4];
#pragma unroll
      for (int q = 0; q < 4; ++q) { const int k = tid + 512 * q; gk[q] = kvn[k];
#pragma unroll
          for (int j = 0; j < 4; ++j) wv[q][j] = *(const f32x4*)(wf + (size_t)k * NH + 4 * j); }
#pragma unroll
      for (int q = 0; q < 4; ++q) { const int pos = 512 * q + 64 * (tid & 7) + (tid >> 3);
#pragma unroll
          for (int j = 0; j < 4; ++j)
#pragma unroll
              for (int c = 0; c < 4; ++c) wfg[(4 * j + c) * DM + pos] = wv[q][j][c] * gk[q]; } }
    __syncthreads();
    const int base = 33 * wgid;
    logf_task(a, wfg, base + 4 * wave, 4, lane);
    if (wave == 0) logf_task(a, wfg, base + 32, 1, lane);
    __syncthreads();
}
__device__ __forceinline__ void cumsum_phase(const Args& a_, LAS unsigned char* lds, int wgid, int tid) {
    int z = 0; asm volatile("" : "+s"(z)); asm volatile("" : "+v"(tid));
    struct { unsigned char* ws; } a; a.ws = a_.ws + z;
    const float* LF = (const float*)(a.ws + WS_LOGF);
    if (wgid >= 0 && wgid < NH) {
        const int h = wgid, lane = tid & 63, wave = tid >> 6; LAS float* wt = (LAS float*)lds;
        float v[16]; float run = 0.f;
#pragma unroll
        for (int i = 0; i < 16; ++i) { run += LF[(size_t)(16 * tid + i) * NH + h]; v[i] = run; }
        float incl = run;
#pragma unroll
        for (int o = 1; o < 64; o <<= 1) { const float t = lane_get(incl, lane >= o ? lane - o : lane); if (lane >= o) incl += t; }
        __syncthreads();
        if (lane == 63) wt[wave] = incl;
        __syncthreads();
        float pre = incl - run;
        for (int w = 0; w < wave; ++w) pre += wt[w];
        float* KX = (float*)(a.ws + WS_KX) + (size_t)h * SEQ + 16 * tid;
#pragma unroll
        for (int i = 0; i < 16; i += 4) *(f32x4*)(KX + i) = (f32x4){-(pre + v[i]) * LOG2E, -(pre + v[i + 1]) * LOG2E, -(pre + v[i + 2]) * LOG2E, -(pre + v[i + 3]) * LOG2E};
        __syncthreads();
    } else if (wgid == NH) {
        if (tid < 256) { const int b = tid >> 4, h = tid & 15; float c = ((const float*)(a.ws + WS_CEND))[tid]; float* dst = (float*)(a.ws + WS_CKS) + (size_t)tid * CKS_STRIDE + PAST;
#pragma unroll 1
            for (int i = 0; i < DEC_T; ++i) { c += LF[(size_t)(SEQ + DEC_T * b + i) * NH + h]; dst[i] = -c * LOG2E; } }
    }
}

__device__ __forceinline__ void kn_phase(const Args& a_, int wgid, int tid) {
    int z = 0; asm volatile("" : "+s"(z)); asm volatile("" : "+v"(tid));
    const bf16* Kb = (const bf16*)(a_.ws + z + WS_KB); unsigned* kn2 = (unsigned*)(a_.ws + z + WS_CTL) + CW_KN2;
    const int h = wgid & 15, key = 512 * (wgid >> 4) + tid;
    const u32x4* p = (const u32x4*)(Kb + (size_t)key * DM + h * HD); float ks = 0.f;
#pragma unroll
    for (int i = 0; i < 16; ++i) { const u32x4 w = p[i]; const unsigned ww[4] = {w.x, w.y, w.z, w.w};
#pragma unroll
        for (int j = 0; j < 4; ++j) { const float lo = bf2f(ww[j] & 0xffffu), hi = bf2f(ww[j] >> 16); ks += lo * lo + hi * hi; } }
    ks = fmaxf(ks, xor_get<1>(ks)); ks = fmaxf(ks, xor_get<2>(ks)); ks = fmaxf(ks, xor_get<4>(ks)); ks = fmaxf(ks, xor_get<8>(ks)); ks = fmaxf(ks, xor_get<16>(ks)); ks = max32(ks);
    if ((tid & 63) == 0) atomicMax(kn2 + h, __builtin_bit_cast(unsigned, ks));
}

__global__ void __launch_bounds__(NWAVES * 64, 2) yoco_fwd(Args args) {
    extern __shared__ __attribute__((aligned(16))) unsigned char lds_raw[];
    LAS unsigned char* lds = (LAS unsigned char*)lds_raw;
    volatile LAS unsigned* MISC = (volatile LAS unsigned*)(lds + MISC_OFF);
    LAS float* rtab = (LAS float*)(lds + RTAB_OFF);
    const int wave = __builtin_amdgcn_readfirstlane((int)threadIdx.x >> 6);
    const int G = gridDim.x, bx = blockIdx.x;
    unsigned char* ws = args.ws;
    unsigned* ctl = (unsigned*)(ws + WS_CTL);
    for (int u = threadIdx.x; u < (LDS_BYTES - MISC_OFF) / 4; u += NWAVES * 64) ((LAS unsigned*)(lds + MISC_OFF))[u] = 0u;
    __syncthreads();
#if MK_PER_PHASE
#define GRID_BAR() do { } while (0)
#else
    XcdBarrier bar = xcd_barrier_post(ctl + CW_BAR, MISC + 8);
#define GRID_BAR() xcd_barrier(bar)
#endif
    int ph = 0;
#define PHASE_ON() (ph >= args.ph_lo && ph < args.ph_hi)
#define PHASE_END() do { if (ph + 1 < args.ph_hi && ph >= args.ph_lo) GRID_BAR(); ++ph; } while (0)


#define LAUNDER() unsigned m_ = ~0u; int Gp = G, bxp = bx, zz_ = 0; asm volatile("" : "+s"(m_), "+s"(Gp), "+s"(bxp), "+s"(zz_)); const int lanep = (int)__builtin_amdgcn_mbcnt_hi(m_, __builtin_amdgcn_mbcnt_lo(m_, 0u)), tidp = wave * 64 + lanep; unsigned char* wz = ws + zz_; bf16* XBz = (bf16*)(wz + WS_XB); float* Pz = (float*)(wz + WS_P); bf16* ACTz = (bf16*)(wz + WS_ACT); (void)XBz; (void)Pz; (void)ACTz; (void)lanep; (void)tidp
    if (PHASE_ON() && !(DIS & 1)) for (int rp = 0; rp < REPS(1); ++rp) { if (rp) GRID_BAR(); LAUNDER(); const int vcup = (Gp % 8 == 0) ? (bxp % 8) * (Gp / 8) + bxp / 8 : bxp; prologue(args, lds, vcup, Gp, wave, lanep); }
    PHASE_END();

    for (int hl = 0; hl < 8; ++hl) {
        const int l = hl >> 1, f = hl & 1;
        if (hl == 4) {
            if (PHASE_ON() && !(DIS & 2)) for (int rp = 0; rp < REPS(2); ++rp) { if (rp) GRID_BAR(); LAUNDER(); logf_phase(args, lds, bxp, tidp); }
            PHASE_END();
        }
        if (PHASE_ON()) {
            if (hl == 4 && !(DIS & 4)) { LAUNDER(); cumsum_phase(args, lds, bxp - 188, tidp); }
            if (!(DIS & 8)) for (int rp = 0; rp < REPS(8); ++rp) { if (rp) GRID_BAR(); LAUNDER(); pg8::Gemm g{XBz, (const bf16*)(wz + WS_WGU + (size_t)hl * SZ_WGU), M, 2 * FF, DM}; pg8::HybridOrder S; S.init(M, 2 * FF, DM, Gp, bxp, false);
              build_rtab(rtab, Pz, S, tidp);
              pg8::EpiSwiGLU E{ACTz, rtab};
              pg8::gemm_phase<pg8::EpiSwiGLU>(lds, g, S, E, wz + WS_SLAB, tidp); }
            if (hl == 4 && !(DIS & 16)) for (int rp = 0; rp < REPS(16); ++rp) {
                if (rp) GRID_BAR(); LAUNDER(); pg8::Gemm g{XBz, (const bf16*)(wz + WS_WKV), M, 2 * DM, DM}; pg8::HybridOrder S; S.init(M, 2 * DM, DM, Gp, (bxp + 84) % Gp, false);
                build_rtab(rtab, Pz, S, tidp);
                pg8::EpiKV E{args.out + zz_, (bf16*)(wz + WS_KB), (bf16*)(wz + WS_VB), rtab};
                pg8::gemm_phase<pg8::EpiKV>(lds, g, S, E, wz + WS_SLAB, tidp);
            }
        }
        PHASE_END();
        if (PHASE_ON() && !(DIS & 32)) for (int rp = 0; rp < REPS(32); ++rp) {
            if (rp) GRID_BAR(); LAUNDER();
            if (hl == 4 && rp == 0) kn_phase(args, bxp, tidp); pg8::Gemm g{ACTz, (const bf16*)(wz + WS_WD + (size_t)hl * SZ_WD), SEQ, DM, FF}; pg8::HybridOrder S; S.init(SEQ, DM, FF, Gp, bxp, false);
            pg8::EpiResid E{XBz, Pz, rp + 1 == REPS(32) ? 0.5f : 0.0f}; pg8::SEpiResid SE{XBz, Pz, E.alpha, (LAS float*)(lds + MISC_OFF + 1024)};
            pg8::gemm_phase<pg8::EpiResid, true, true, pg8::SEpiResid>(lds, g, S, E, wz + WS_SLAB, tidp, SE);
        }
        PHASE_END();
        if (f == 0) {
            if (l < 2) {
                if (PHASE_ON() && !(DIS & 64)) for (int rp = 0; rp < REPS(64); ++rp) {
                    if (rp) GRID_BAR(); LAUNDER(); pg8::Gemm g{XBz, (const bf16*)(wz + WS_WIN + (size_t)l * SZ_WIN), SEQ, 2 * DG, DM}; pg8::HybridOrder S; S.init(SEQ, 2 * DG, DM, Gp, bxp, false);
                    build_rtab(rtab, Pz, S, tidp); build_srt((LAS float*)(lds + MISC_OFF + 2048), Pz, S, tidp);
                    pg8::EpiGelu E{(bf16*)(wz + WS_U), (bf16*)(wz + WS_V), (f32x2*)(wz + WS_S1), rtab}; pg8::SEpiGelu SE{(bf16*)(wz + WS_U), (bf16*)(wz + WS_V), (f32x2*)(wz + WS_S1), (const LAS float*)(lds + MISC_OFF + 2048), (LAS float*)(lds + MISC_OFF + 1024)};
                    pg8::gemm_phase<pg8::EpiGelu, true, true, pg8::SEpiGelu>(lds, g, S, E, wz + WS_SLAB, tidp, SE);
                }
                PHASE_END();
                if (PHASE_ON() && !(DIS & 128)) for (int rp = 0; rp < REPS(128); ++rp) {
                    if (rp) GRID_BAR(); LAUNDER(); for (int u = bxp; u < 320; u += Gp) {
                        if (u < 256) mix_unit(args, lds, l, 128 * (u >> 2), 128, u & 3, nullptr, tidp);
                        else { const int b = (u - 256) >> 2; mix_unit(args, lds, l, SEQ + DEC_T * b, DEC_T, (u - 256) & 3, args.out + zz_ + O_GV + ((size_t)l * NSAMP + DEC_T * b) * DG, tidp); }
                    }
                }
                PHASE_END();
                if (PHASE_ON() && !(DIS & 256)) for (int rp = 0; rp < REPS(256); ++rp) {
                    if (rp) GRID_BAR(); LAUNDER(); pg8::Gemm g{(const bf16*)(wz + WS_G), (const bf16*)(wz + WS_WOUT + (size_t)l * SZ_WOUT), SEQ, DM, DG}; pg8::HybridOrder S; S.init(SEQ, DM, DG, Gp, bxp, false);
                    pg8::EpiResid E{XBz, Pz, rp + 1 == REPS(256) ? 1.0f : 0.0f}; pg8::SEpiResid SE{XBz, Pz, E.alpha, (LAS float*)(lds + MISC_OFF + 1024)};
                    pg8::gemm_phase<pg8::EpiResid, true, true, pg8::SEpiResid>(lds, g, S, E, wz + WS_SLAB, tidp, SE);
                }
                PHASE_END();
            } else {
                if (PHASE_ON() && !(DIS & 512)) for (int rp = 0; rp < REPS(512); ++rp) {
                    if (rp) GRID_BAR(); LAUNDER(); pg8::Gemm g{XBz, (const bf16*)(wz + WS_WQ + (size_t)(l - 2) * SZ_WQ), SEQ, DM, DM}; pg8::HybridOrder S; S.init(SEQ, DM, DM, Gp, bxp, false);
                    build_rtab(rtab, Pz, S, tidp); build_srt((LAS float*)(lds + MISC_OFF + 2048), Pz, S, tidp);
                    pg8::EpiQ E{(bf16*)(wz + WS_QB), rtab, Pz}; pg8::SEpiQ SE{(bf16*)(wz + WS_QB), (const LAS float*)(lds + MISC_OFF + 2048)};
                    pg8::gemm_phase<pg8::EpiQ, true, true, pg8::SEpiQ>(lds, g, S, E, wz + WS_SLAB, tidp, SE);
                }
                PHASE_END();
                if (PHASE_ON()) {
                    LAUNDER();
                    const bf16* Qb = (const bf16*)(wz + WS_QB); const bf16* Kb = (const bf16*)(wz + WS_KB); const bf16* Vb = (const bf16*)(wz + WS_VB); const float* KX = (const float*)(wz + WS_KX); bf16* Ob = (bf16*)(wz + WS_OB);
                    __syncthreads();
                    for (int rp = 0; rp < REPS(1024); ++rp) {
                        unsigned* tkc = (unsigned*)(wz + WS_CTL) + CW_TK + 64 * ((l - 2) * 2 + rp); LAS unsigned* tkw = (LAS unsigned*)(lds + 75776);
                        const unsigned* kn2p = (const unsigned*)(wz + WS_CTL) + CW_KN2;
                        for (;;) {
                            if (tidp == 0) *tkw = __hip_atomic_fetch_add(tkc, 1u, __ATOMIC_RELAXED, __HIP_MEMORY_SCOPE_AGENT);
                            __syncthreads();
                            const int it = (int)__builtin_amdgcn_readfirstlane(*tkw);
                            if (it >= 768) break;
                            if (it < 256 && (it & 1)) { attn_sample(args, lds, it >> 1, tidp); continue; }
                            if (it >= 256 && it < 384) { attn_sample(args, lds, it - 128, tidp); continue; }
                            const int ip = it < 256 ? (it >> 1) : it - 256, h = ip & 15, qb = 31 - (ip >> 4);
                            fa::BlockRef b0;
                            b0.Q = Qb + (size_t)(qb * 256) * DM + h * HD; b0.O = Ob + (size_t)(qb * 256) * DM + h * HD; b0.K = Kb + h * HD; b0.V = Vb + h * HD; b0.KX = KX + (size_t)h * SEQ; b0.P0 = qb * 256;
                            fa::Seam S;
                            const int j_lo = fa::prime(b0, __builtin_bit_cast(float, kn2p[h]), (char*)lds_raw, S, wave);
                            fa::block(b0, j_lo, (char*)lds_raw, S, wave);
                        }
                        VM_WAIT(); __syncthreads();
                    }
                }
                PHASE_END();
                if (PHASE_ON() && !(DIS & 4096)) for (int rp = 0; rp < REPS(4096); ++rp) {
                    if (rp) GRID_BAR(); LAUNDER(); pg8::Gemm g{(const bf16*)(wz + WS_OB), (const bf16*)(wz + WS_WO + (size_t)(l - 2) * SZ_WQ), SEQ, DM, DM}; pg8::HybridOrder S; S.init(SEQ, DM, DM, Gp, bxp, false);
                    pg8::EpiResid E{XBz, Pz, rp + 1 == REPS(4096) ? 1.0f : 0.0f}; pg8::SEpiResid SE{XBz, Pz, E.alpha, (LAS float*)(lds + MISC_OFF + 1024)};
                    pg8::gemm_phase<pg8::EpiResid, true, true, pg8::SEpiResid>(lds, g, S, E, wz + WS_SLAB, tidp, SE);
                }
                PHASE_END();
            }
        }
    }
    if (PHASE_ON() && !(DIS & 8192)) for (int rp = 0; rp < REPS(8192); ++rp) {
        if (rp) GRID_BAR(); LAUNDER(); const int lane = lanep; const int vcup = (Gp % 8 == 0) ? (bxp % 8) * (Gp / 8) + bxp / 8 : bxp; const bf16* X = XBz; float* P = Pz;
        const float* gn = args.in[I_FN + zz_]; const int gw = vcup * NWAVES + wave, NGW = Gp * NWAVES;
        f32x4 gg[8];
#pragma unroll
        for (int j = 0; j < 8; ++j) gg[j] = *(const f32x4*)(gn + 256 * j + 4 * lane);
        u32x2 xw[8]; float sp = 0.f; int m = gw;
        if (m < M) { sp = lane < 32 ? P[(size_t)m * 32 + lane] : 0.f;
#pragma unroll
            for (int j = 0; j < 8; ++j) xw[j] = *(const u32x2*)(X + (size_t)m * DM + 256 * j + 4 * lane); }
        while (m < M) {
            const int mn = m + NGW; u32x2 xn[8]; float sn = 0.f;
#pragma unroll
            for (int j = 0; j < 8; ++j) xn[j] = xw[j];
            if (mn < M) { sn = lane < 32 ? P[(size_t)mn * 32 + lane] : 0.f;
#pragma unroll
                for (int j = 0; j < 8; ++j) xn[j] = *(const u32x2*)(X + (size_t)mn * DM + 256 * j + 4 * lane); }
            const float s = wave_sum(sp);
            const float r = 1.0f / sqrtf(s * (1.0f / DM) + RMS_EPS);
            float* dst = m < SEQ ? args.out + O_YP + (size_t)m * DM : args.out + O_YS + (size_t)(m - SEQ) * DM;
#pragma unroll
            for (int j = 0; j < 8; ++j) { const u32x2 xr = xw[j]; const f32x4 v = (f32x4){bf2f(xr.x & 0xffffu), bf2f(xr.x >> 16), bf2f(xr.y & 0xffffu), bf2f(xr.y >> 16)};
                *(f32x4*)(dst + 256 * j + 4 * lane) = v * r * gg[j]; }
#pragma unroll
            for (int j = 0; j < 8; ++j) xw[j] = xn[j];
            sp = sn; m = mn;
        }
    }
    PHASE_END();
}
constexpr int N_PHASES = 1 + 1 + 8 * 2 + 4 * 3 + 1;

extern "C" void kernel_launch(void* const* d_in, const int* in_sizes, int n_in, void* d_out, int out_size, void* d_ws, size_t ws_size, hipStream_t stream) {
    static int grid = 0;
    if (grid == 0) {
        if (n_in != 28 || (size_t)out_size != O_END || ws_size < WS_END) { fprintf(stderr, "kernel_launch: unexpected shapes (n_in %d, out %d, ws %zu; need 28, %zu, >= %zu)\n", n_in, out_size, ws_size, (size_t)O_END, (size_t)WS_END); grid = -1; return; }
        int dev = 0, cus = 0, per_cu = 0;
        if (hipGetDevice(&dev) != hipSuccess || hipDeviceGetAttribute(&cus, hipDeviceAttributeMultiprocessorCount, dev) != hipSuccess) { grid = -1; return; }
        if (hipFuncSetAttribute((const void*)yoco_fwd, hipFuncAttributeMaxDynamicSharedMemorySize, LDS_BYTES) != hipSuccess) { fprintf(stderr, "kernel_launch: hipFuncSetAttribute failed\n"); grid = -1; return; }
        if (hipOccupancyMaxActiveBlocksPerMultiprocessor(&per_cu, (const void*)yoco_fwd, NWAVES * 64, LDS_BYTES) != hipSuccess || per_cu < 1) fprintf(stderr, "kernel_launch: occupancy query says %d\n", per_cu);
        (void)hipGetLastError();
        grid = cus;
        if (cus < 256) { fprintf(stderr, "kernel_launch: needs 256 co-resident workgroups, device has %d CUs\n", cus); grid = -1; return; }
        grid = 256;
    }
    if (grid < 0) return;
    (void)hipMemsetAsync((char*)d_ws + WS_CTL, 0, CTL_ZERO_BYTES, stream);
    Args a{};
    for (int i = 0; i < 28; ++i) a.in[i] = (const float*)d_in[i];
    a.out = (float*)d_out; a.ws = (unsigned char*)d_ws;
#if MK_PER_PHASE
    for (int p = 0; p < N_PHASES; ++p) { a.ph_lo = p; a.ph_hi = p + 1; hipLaunchKernelGGL(yoco_fwd, dim3(grid), dim3(NWAVES * 64), LDS_BYTES, stream, a); }
#else
    a.ph_lo = 0; a.ph_hi = N_PHASES;
    hipLaunchKernelGGL(yoco_fwd, dim3(grid), dim3(NWAVES * 64), LDS_BYTES, stream, a);
#endif
    const hipError_t le = hipPeekAtLastError();
    if (le != hipSuccess) fprintf(stderr, "kernel_launch: launch failed: %s\n", hipGetErrorName(le));
}
```

```cpp
#include <hip/hip_runtime.h>
#include <cstdio>
#include <cstdint>

#ifndef DIS
#define DIS 0
#endif
#ifndef REP_MASK
#define REP_MASK 0
#endif
#define REPS(bit) ((REP_MASK & (bit)) ? 2 : 1)
#ifndef MK_PER_PHASE
#define MK_PER_PHASE 0
#endif

#define LAS __attribute__((address_space(3)))
#define GAS __attribute__((address_space(1)))
typedef unsigned short bf16;
typedef short bf16x8 __attribute__((ext_vector_type(8)));
typedef short s16x4 __attribute__((ext_vector_type(4)));
typedef float f32x2 __attribute__((ext_vector_type(2)));
typedef float f32x4 __attribute__((ext_vector_type(4)));
typedef float f32x16 __attribute__((ext_vector_type(16)));
typedef unsigned u32x4 __attribute__((ext_vector_type(4)));
typedef unsigned u32x2 __attribute__((ext_vector_type(2)));
typedef GAS unsigned gu32;

constexpr int DM = 2048, SEQ = 8192, NSAMP = 256, M = SEQ + NSAMP, FF = 5632, DG = 4096, NH = 16, HD = 128, PAST = 2048, DEC_T = 16, DEC_B = 16;
constexpr float RMS_EPS = 1e-6f, LN_EPS = 1e-5f, LOG2E = 1.4426950408889634f, LN2 = 0.6931471805599453f;
constexpr int CKS_STRIDE = 2112;
constexpr size_t O_YP = 0, O_YS = O_YP + (size_t)SEQ * DM, O_KP = O_YS + (size_t)NSAMP * DM, O_VP = O_KP + (size_t)SEQ * DM, O_LP = O_VP + (size_t)SEQ * DM,
                 O_KS = O_LP + (size_t)SEQ * NH, O_VS = O_KS + (size_t)NSAMP * DM, O_LS = O_VS + (size_t)NSAMP * DM, O_GV = O_LS + (size_t)NSAMP * NH, O_END = O_GV + (size_t)2 * NSAMP * DG;
constexpr size_t MiB = 1u << 20;
constexpr size_t WS_CTL = 0, CTL_ZERO_BYTES = 64 * 1024;
constexpr size_t WS_WGU = 1 * MiB, SZ_WGU = 44 * MiB, WS_WD = WS_WGU + 8 * SZ_WGU, SZ_WD = 22 * MiB, WS_WIN = WS_WD + 8 * SZ_WD, SZ_WIN = 32 * MiB, WS_WOUT = WS_WIN + 2 * SZ_WIN, SZ_WOUT = 16 * MiB,
                 WS_WKV = WS_WOUT + 2 * SZ_WOUT, WS_WQ = WS_WKV + 16 * MiB, SZ_WQ = 8 * MiB, WS_WO = WS_WQ + 2 * SZ_WQ, WS_X = WS_WO + 2 * SZ_WQ, WS_XB = WS_X + 66 * MiB, WS_ACT = WS_XB + 33 * MiB,
                 WS_U = WS_ACT + 91 * MiB, WS_V = WS_U + 66 * MiB, WS_G = WS_V + 66 * MiB, WS_QB = WS_G + 66 * MiB, WS_KB = WS_QB + 33 * MiB, WS_VB = WS_KB + 33 * MiB, WS_OB = WS_VB + 33 * MiB,
                 WS_P = WS_OB + 33 * MiB, WS_S1 = WS_P + 2 * MiB, WS_LOGF = WS_S1 + 5 * MiB, WS_KX = WS_LOGF + 1 * MiB, WS_CKS = WS_KX + 2 * MiB, WS_CEND = WS_CKS + 3 * MiB, WS_SLAB = WS_CEND + 1 * MiB, WS_END = WS_SLAB + 128 * MiB;
static_assert((size_t)11264 * 2048 * 2 == SZ_WGU && (size_t)2048 * 5632 * 2 == SZ_WD && (size_t)M * DM * 4 == 66 * MiB && (size_t)M * FF * 2 <= 91 * MiB && (size_t)M * DG * 2 == 66 * MiB, "ws map");
static_assert((size_t)M * 32 * 4 <= 2 * MiB && (size_t)M * 64 * 8 <= 5 * MiB && (size_t)NH * SEQ * 4 <= 2 * MiB && (size_t)256 * CKS_STRIDE * 4 <= 3 * MiB, "ws map 2");
constexpr int CW_BAR = 4096;
constexpr int CW_TK = 8192, CW_KN2 = 8192 + 1024;
constexpr int RING_BYTES = 131072, RTAB_OFF = RING_BYTES, RTAB_BYTES = 8 * 256 * 4, MISC_OFF = RTAB_OFF + RTAB_BYTES, LDS_BYTES = 147456;
constexpr int NWAVES = 8;

__device__ __forceinline__ unsigned cvt_pk_bf16(float lo, float hi) { unsigned r; asm volatile("v_cvt_pk_bf16_f32 %0, %1, %2" : "=v"(r) : "v"(lo), "v"(hi)); return r; }
__device__ __forceinline__ unsigned f2bf(float f) { unsigned u = __builtin_bit_cast(unsigned, f); return (u + 0x7fffu + ((u >> 16) & 1u)) >> 16; }
__device__ __forceinline__ float bf2f(unsigned b) { return __builtin_bit_cast(float, b << 16); }
__device__ __forceinline__ unsigned pk2(float lo, float hi) { return f2bf(lo) | (f2bf(hi) << 16); }
#define LDS_WAIT() asm volatile("s_waitcnt lgkmcnt(0)" ::: "memory")
#define VM_WAIT() asm volatile("s_waitcnt vmcnt(0)" ::: "memory")
template <int X> __device__ __forceinline__ float xor_get(float v) { static_assert(X == 1 || X == 2 || X == 4 || X == 8 || X == 16, "swizzle xor"); return __builtin_bit_cast(float, __builtin_amdgcn_ds_swizzle(__builtin_bit_cast(int, v), 0x1F | (X << 10))); }
__device__ __forceinline__ float sum32(float v) { auto rr = __builtin_amdgcn_permlane32_swap(__float_as_uint(v), __float_as_uint(v), false, false); return __uint_as_float(rr[0]) + __uint_as_float(rr[1]); }
__device__ __forceinline__ float max32(float v) { auto rr = __builtin_amdgcn_permlane32_swap(__float_as_uint(v), __float_as_uint(v), false, false); return fmaxf(__uint_as_float(rr[0]), __uint_as_float(rr[1])); }
__device__ __forceinline__ float lane_get(float v, int src_lane) { return __builtin_bit_cast(float, __builtin_amdgcn_ds_bpermute(src_lane << 2, __builtin_bit_cast(int, v))); }
__device__ __forceinline__ float wave_sum(float v) { v += xor_get<1>(v); v += xor_get<2>(v); v += xor_get<4>(v); v += xor_get<8>(v); v += xor_get<16>(v); return sum32(v); }
__device__ __forceinline__ f32x2 gelu_pk(f32x2 v) {
    const f32x2 av = __builtin_elementwise_abs(v), d = av * 0.2316418882f + 1.0f;
    f32x2 t; t.x = __builtin_amdgcn_rcpf(d.x); t.y = __builtin_amdgcn_rcpf(d.y);
    f32x2 q = t * 0.5307027145f + (-0.7265760135f); q = q * t + 0.7107068705f; q = q * t + (-0.142248368f); q = q * t + 0.127414796f; q = q * t;
    const f32x2 s = (v * v) * (-0.72134752044f);
    f32x2 e; e.x = __builtin_amdgcn_exp2f(s.x); e.y = __builtin_amdgcn_exp2f(s.y);
    const f32x2 m = v * (q * e), r = v - m;
    f32x2 o; o.x = v.x < 0.f ? m.x : r.x; o.y = v.y < 0.f ? m.y : r.y; return o;
}
__device__ __forceinline__ float silu_f(float x) { return x * __builtin_amdgcn_rcpf(1.0f + __builtin_amdgcn_exp2f(-x * LOG2E)); }

namespace pg8 {
constexpr int BM = 256, BK = 64, HALF = 128, HTB = HALF * BK * 2, STAGE_BYTES = 8 * HTB, NXCD = 8, WGM = 4;
__host__ __device__ __forceinline__ int lds_byte(int r, int c) { const int st = (r >> 4) * 2 + (c >> 5), rr = r & 15, cc = c & 31, ob = rr * 64 + cc * 2; return st * 1024 + (ob ^ (((ob >> 9) & 1) << 5)); }
__host__ __device__ __forceinline__ void stage_rc(int b, int& R, int& C) { const int st = b / 1024, sb = b % 1024, swz = sb ^ (((sb >> 9) & 1) << 5); R = (st >> 1) * 16 + swz / 64; C = (st & 1) * 32 + (swz % 64) / 2; }
__host__ __device__ __forceinline__ int perm32(int rho) { const int n = rho >> 4, i = rho & 15; return 8 * (i >> 2) + 4 * n + (i & 3); }
struct Unit { int pm, pn, sw; };
struct Gemm { const bf16* A; const bf16* Bt; int M, N, K; };
struct Seg { int pm, pn, t0, t1, slot; };
struct HybridOrder {
    int nM, nN, nwg, G, c, T, q, R, lo, hi; bool split;
    __device__ __forceinline__ void init(int M_, int N_, int K_, int G_, int c_, bool split_) { nM = M_ / BM; nN = N_ / BM; nwg = nM * nN; G = G_; c = c_; T = K_ / (2 * BK); q = nwg / G; R = nwg - q * G; split = split_ && R > 0;
        const long W = (long)R * T; lo = (int)((long)c * W / G); hi = (int)((long)(c + 1) * W / G); }
    __device__ __forceinline__ void decode(int L, int& pm, int& pn) const {
        int wgid = L; { const int qq = nwg / NXCD, r = nwg % NXCD, xcd = wgid % NXCD, off = wgid / NXCD; wgid = (xcd < r ? xcd * (qq + 1) : r * (qq + 1) + (xcd - r) * qq) + off; }
        const int nig = WGM * nN, gid = wgid / nig, fm = gid * WGM, gsz = (nM - fm) < WGM ? (nM - fm) : WGM;
        pm = fm + ((wgid % nig) % gsz); pn = (wgid % nig) / gsz;
    }
    __device__ __forceinline__ bool seg(int i, Seg& s) const {
        if (!split || i < q) { const int L = i * G + c; if (L >= nwg) return false; decode(L, s.pm, s.pn); s.t0 = 0; s.t1 = T; s.slot = -1; return true; }
        const int j = i - q, r = lo / T + j, b = r * T; const int st = lo > b ? lo : b, en = hi < b + T ? hi : b + T; if (st >= en) return false;
        decode(q * G + r, s.pm, s.pn); s.t0 = st - b; s.t1 = en - b; s.slot = j; return true;
    }
};
struct NoSEpi { static constexpr bool ON = false; };
constexpr int SOFF = MISC_OFF + 4096;
template <class Epi, bool ALIGN_EPI = true, bool SP2 = true, class SEpi = NoSEpi>
__device__ __forceinline__ void gemm_phase(LAS unsigned char* lds, const Gemm g, const HybridOrder& S, const Epi& E, unsigned char* slab, int tid_, const SEpi& SE = SEpi()) {
    constexpr bool SAMP = SEpi::ON;
    static_assert(!SAMP || (SP2 && ALIGN_EPI), "sample piece: SP2 path only");
    asm volatile("" : "+v"(tid_));
    const int tid = tid_, wid = __builtin_amdgcn_readfirstlane(tid >> 6), lane = tid & 63, wr = wid >> 2, wc = wid & 3, fr = lane & 15, fq = lane >> 4;
    const int K = g.K;
    unsigned voffA[2], voffB[2];
#pragma unroll
    for (int i = 0; i < 2; ++i) { int R, C; stage_rc(tid * 16 + i * 8192, R, C); const int Rb = Epi::PERM ? ((R & ~31) + perm32(R & 31)) : R;
        voffA[i] = (unsigned)(R * K + C) * 2u; voffB[i] = (unsigned)(Rb * K + C) * 2u; }
    unsigned voffS = 0u; int soff = 0;
    if constexpr (SAMP) { int R, C; stage_rc(wid * 256 + lane * 4, R, C); voffS = (unsigned)(R * K + C) * 2u; soff = lds_byte(fr, fq * 8); }
    const size_t kstep = (size_t)(BK * 2);
    const size_t hstep = (size_t)HALF * K * 2;
    const size_t tstep = 2 * hstep;
    const unsigned ldsw = (unsigned)wid * 1024u;
    const int aoff = lds_byte(wr * 64 + fr, fq * 8), boff = lds_byte(wc * 32 + fr, fq * 8);
#define PG8_SA(b, h) (((b) * 2 + (h)) * HTB)
#define PG8_SB(b, h) ((4 + (b) * 2 + (h)) * HTB)
#define PG8_STAGE(bufoff, gbase, voff) do { _Pragma("unroll") for (int _i = 0; _i < 2; ++_i) \
        __builtin_amdgcn_global_load_lds((const unsigned*)((const char*)(gbase) + (voff)[_i]), (LAS unsigned*)(lds + (bufoff) + ldsw + _i * 8192), 16, 0, 0); } while (0)
#define PG8_LDA(dst, b, h) do { _Pragma("unroll") for (int m = 0; m < 4; ++m) _Pragma("unroll") for (int k = 0; k < 2; ++k) dst[m][k] = *(const LAS bf16x8*)(lds + PG8_SA(b, h) + aoff + m * 2048 + k * 1024); } while (0)
#define PG8_LDB(dst, b, h) do { _Pragma("unroll") for (int n = 0; n < 2; ++n) _Pragma("unroll") for (int k = 0; k < 2; ++k) dst[n][k] = *(const LAS bf16x8*)(lds + PG8_SB(b, h) + boff + n * 2048 + k * 1024); } while (0)
#define PG8_MMA(ai, bj, At, Bt) do { __builtin_amdgcn_s_setprio(1); _Pragma("unroll") for (int m = 0; m < 4; ++m) _Pragma("unroll") for (int n = 0; n < 2; ++n) _Pragma("unroll") for (int k = 0; k < 2; ++k) \
        acc[ai][bj][m][n] = __builtin_amdgcn_mfma_f32_16x16x32_bf16(Bt[n][k], At[m][k], acc[ai][bj][m][n], 0, 0, 0); __builtin_amdgcn_s_setprio(0); } while (0)
#define PG8_SS(b) (SOFF + (b) * 2048)
#define PG8_STAGE_S(b, gbase) do { if constexpr (SAMP) __builtin_amdgcn_global_load_lds((const unsigned*)((const char*)(gbase) + voffS), (LAS unsigned*)(lds + PG8_SS(b) + wid * 256), 4, 0, 0); } while (0)
#define PG8_LDS_S(b) do { if constexpr (SAMP) { As_[0] = *(const LAS bf16x8*)(lds + PG8_SS(b) + soff); As_[1] = *(const LAS bf16x8*)(lds + PG8_SS(b) + soff + 1024); Bs_[0] = wr ? B1[1][0] : B1[0][0]; Bs_[1] = wr ? B1[1][1] : B1[0][1]; } } while (0)
#define PG8_MS(Bx, n_) do { acc2 = __builtin_amdgcn_mfma_f32_16x16x32_bf16(Bx[n_][0], As_[0], acc2, 0, 0, 0); acc2 = __builtin_amdgcn_mfma_f32_16x16x32_bf16(Bx[n_][1], As_[1], acc2, 0, 0, 0); } while (0)
#define PG8_MMA_S() do { asm volatile("" : "+v"(As_[0]), "+v"(As_[1]), "+v"(Bs_[0]), "+v"(Bs_[1])); __builtin_amdgcn_s_setprio(1); acc2 = __builtin_amdgcn_mfma_f32_16x16x32_bf16(Bs_[0], As_[0], acc2, 0, 0, 0); acc2 = __builtin_amdgcn_mfma_f32_16x16x32_bf16(Bs_[1], As_[1], acc2, 0, 0, 0); __builtin_amdgcn_s_setprio(0); asm volatile("" : "+v"(acc2)); } while (0)
#define PG8_WAIT_VS(n, ns) do { if constexpr (SAMP) asm volatile("s_waitcnt vmcnt(" #ns ")" ::: "memory"); else asm volatile("s_waitcnt vmcnt(" #n ")" ::: "memory"); } while (0)
#define PG8_WAIT_V(n) asm volatile("s_waitcnt vmcnt(" #n ")" ::: "memory")
#define PG8_WAIT_L(n) asm volatile("s_waitcnt lgkmcnt(" #n ")" ::: "memory")
#define PG8_BAR __builtin_amdgcn_s_barrier()
#define PG8_SCHED __builtin_amdgcn_sched_barrier(0)
    Seg cur, nxt; int ui = 0;
    if (!S.seg(0, cur)) return;
    f32x4 acc[2][2][4][2];
#pragma unroll
    for (int a = 0; a < 2; ++a)
#pragma unroll
        for (int b = 0; b < 2; ++b)
#pragma unroll
            for (int m = 0; m < 4; ++m)
#pragma unroll
                for (int n = 0; n < 2; ++n) acc[a][b][m][n] = (f32x4){0.f, 0.f, 0.f, 0.f};
    bf16x8 At[4][2], B0[2][2], B1[2][2];
    bf16x8 As_[2], Bs_[2]; f32x4 acc2 = (f32x4){0.f, 0.f, 0.f, 0.f}; (void)As_; (void)Bs_; (void)acc2;
    const size_t sstep = (size_t)16 * K * 2;
    const char* sbase = (const char*)g.A + (size_t)SEQ * K * 2;
    const char* cS = sbase + (size_t)(cur.pm >> 1) * sstep; (void)cS;
    const char* cA = (const char*)g.A + (size_t)cur.pm * tstep + (size_t)cur.t0 * 2 * kstep; const char* cB = (const char*)g.Bt + (size_t)cur.pn * tstep + (size_t)cur.t0 * 2 * kstep;
    long cD = (long)hstep;
    if constexpr (SAMP) { if (!(cur.pm & 1)) { cB += hstep; cD = -(long)hstep; } }
    if constexpr (SAMP) {
        PG8_STAGE(PG8_SB(0, 0), cB, voffB); PG8_STAGE(PG8_SB(0, 1), cB + cD, voffB); PG8_STAGE(PG8_SA(0, 0), cA, voffA); PG8_STAGE_S(0, cS); PG8_STAGE(PG8_SA(0, 1), cA + hstep, voffA);
        if (wr == 1) PG8_BAR;
        PG8_WAIT_V(2); PG8_BAR;
        PG8_STAGE(PG8_SB(1, 0), cB + kstep, voffB); PG8_STAGE(PG8_SA(1, 0), cA + kstep, voffA); PG8_STAGE(PG8_SB(1, 1), cB + cD + kstep, voffB);
        PG8_WAIT_V(6); PG8_BAR;
    } else if constexpr (SP2) {
        PG8_STAGE(PG8_SB(0, 0), cB, voffB); PG8_STAGE(PG8_SB(0, 1), cB + hstep, voffB); PG8_STAGE(PG8_SA(0, 0), cA, voffA); PG8_STAGE(PG8_SA(0, 1), cA + hstep, voffA);
        if (wr == 1) PG8_BAR;
        PG8_WAIT_V(2); PG8_BAR;
        PG8_STAGE(PG8_SB(1, 0), cB + kstep, voffB); PG8_STAGE(PG8_SA(1, 0), cA + kstep, voffA); PG8_STAGE(PG8_SB(1, 1), cB + hstep + kstep, voffB);
        PG8_WAIT_V(6); PG8_BAR;
    } else {
        PG8_STAGE(PG8_SB(0, 0), cB, voffB); PG8_STAGE(PG8_SA(0, 0), cA, voffA); PG8_STAGE(PG8_SB(0, 1), cB + hstep, voffB); PG8_STAGE(PG8_SA(0, 1), cA + hstep, voffA);
        if (wr == 1) PG8_BAR;
        PG8_WAIT_V(4); PG8_BAR;
        PG8_STAGE(PG8_SB(1, 0), cB + kstep, voffB); PG8_STAGE(PG8_SA(1, 0), cA + kstep, voffA); PG8_STAGE(PG8_SB(1, 1), cB + hstep + kstep, voffB);
        PG8_WAIT_V(6); PG8_BAR;
    }
    for (;;) {
        const bool has_next = S.seg(ui + 1, nxt);
        const char* nA = has_next ? (const char*)g.A + (size_t)nxt.pm * tstep + (size_t)nxt.t0 * 2 * kstep : cA; const char* nB = has_next ? (const char*)g.Bt + (size_t)nxt.pn * tstep + (size_t)nxt.t0 * 2 * kstep : cB;
        const char* nS = has_next ? sbase + (size_t)(nxt.pm >> 1) * sstep : cS; (void)nS;
        long nD = cD; if constexpr (SAMP) { if (has_next) { nD = (long)hstep; if (!(nxt.pm & 1)) { nB += hstep; nD = -(long)hstep; } } }
        const int nt = 2 * (cur.t1 - cur.t0);
        for (int t = 0; t < nt; t += 2) {
            const bool last = (t == nt - 2);
            const char* a1 = cA + (size_t)(t + 1) * kstep;
            const char* a2 = last ? nA : cA + (size_t)(t + 2) * kstep; const char* b2 = last ? nB : cB + (size_t)(t + 2) * kstep;
            const char* a3 = a2 + kstep; const char* b3 = b2 + kstep;
            if constexpr (SAMP) {
            const char* s1 = cS + (size_t)(t + 1) * kstep; const char* s2 = last ? nS : cS + (size_t)(t + 2) * kstep; const long d2 = last ? nD : cD;
            PG8_LDB(B0, 0, 0); PG8_LDB(B1, 0, 1); PG8_SCHED; PG8_LDA(At, 0, 0); PG8_STAGE(PG8_SA(1, 1), a1 + hstep, voffA);
            PG8_WAIT_V(8); PG8_WAIT_L(0); PG8_BAR; PG8_STAGE_S(1, s1); PG8_MMA(0, 0, At, B0); PG8_MMA(0, 1, At, B1); PG8_BAR; PG8_SCHED;
            PG8_LDA(At, 0, 1); PG8_STAGE(PG8_SB(0, 0), b2, voffB); PG8_STAGE(PG8_SB(0, 1), b2 + d2, voffB); PG8_STAGE(PG8_SA(0, 0), a2, voffA);
            PG8_WAIT_V(9); PG8_WAIT_L(0); PG8_BAR; PG8_MMA(1, 0, At, B0); PG8_SCHED; PG8_LDS_S(0); PG8_SCHED; PG8_MMA(1, 1, At, B1); PG8_WAIT_L(0); PG8_MMA_S(); PG8_BAR; PG8_SCHED;
            PG8_LDB(B0, 1, 0); PG8_LDB(B1, 1, 1); PG8_SCHED; PG8_LDA(At, 1, 0); PG8_STAGE(PG8_SA(0, 1), a2 + hstep, voffA);
            PG8_WAIT_V(8); PG8_WAIT_L(0); PG8_BAR; PG8_STAGE_S(0, s2); PG8_MMA(0, 0, At, B0); PG8_MMA(0, 1, At, B1); PG8_BAR; PG8_SCHED;
            PG8_LDA(At, 1, 1); PG8_STAGE(PG8_SB(1, 0), b3, voffB); PG8_STAGE(PG8_SB(1, 1), b3 + d2, voffB); PG8_STAGE(PG8_SA(1, 0), a3, voffA);
            PG8_WAIT_V(9); PG8_WAIT_L(0); PG8_BAR; PG8_MMA(1, 0, At, B0); PG8_SCHED; PG8_LDS_S(1); PG8_SCHED; PG8_MMA(1, 1, At, B1); PG8_WAIT_L(0); PG8_MMA_S(); PG8_BAR; PG8_SCHED;
            } else if constexpr (SP2) {
            PG8_LDB(B0, 0, 0); PG8_LDB(B1, 0, 1); PG8_SCHED; PG8_LDA(At, 0, 0); PG8_STAGE(PG8_SA(1, 1), a1 + hstep, voffA);
            PG8_WAIT_V(8); PG8_WAIT_L(0); PG8_BAR; PG8_MMA(0, 0, At, B0); PG8_MMA(0, 1, At, B1); PG8_BAR; PG8_SCHED;
            PG8_LDA(At, 0, 1); PG8_STAGE(PG8_SB(0, 0), b2, voffB); PG8_STAGE(PG8_SB(0, 1), b2 + hstep, voffB); PG8_STAGE(PG8_SA(0, 0), a2, voffA);
            PG8_WAIT_V(8); PG8_WAIT_L(0); PG8_BAR; PG8_MMA(1, 0, At, B0); PG8_MMA(1, 1, At, B1); PG8_BAR; PG8_SCHED;
            PG8_LDB(B0, 1, 0); PG8_LDB(B1, 1, 1); PG8_SCHED; PG8_LDA(At, 1, 0); PG8_STAGE(PG8_SA(0, 1), a2 + hstep, voffA);
            PG8_WAIT_V(8); PG8_WAIT_L(0); PG8_BAR; PG8_MMA(0, 0, At, B0); PG8_MMA(0, 1, At, B1); PG8_BAR; PG8_SCHED;
            PG8_LDA(At, 1, 1); PG8_STAGE(PG8_SB(1, 0), b3, voffB); PG8_STAGE(PG8_SB(1, 1), b3 + hstep, voffB); PG8_STAGE(PG8_SA(1, 0), a3, voffA);
            PG8_WAIT_V(8); PG8_WAIT_L(0); PG8_BAR; PG8_MMA(1, 0, At, B0); PG8_MMA(1, 1, At, B1); PG8_BAR; PG8_SCHED;
            } else {
            PG8_LDB(B0, 0, 0); PG8_SCHED; PG8_LDA(At, 0, 0); PG8_STAGE(PG8_SA(1, 1), a1 + hstep, voffA);
            PG8_WAIT_L(8); PG8_BAR; PG8_WAIT_L(0); PG8_MMA(0, 0, At, B0); PG8_BAR; PG8_SCHED;
            PG8_LDB(B1, 0, 1); PG8_STAGE(PG8_SB(0, 0), b2, voffB);
            PG8_BAR; PG8_WAIT_L(0); PG8_MMA(0, 1, At, B1); PG8_BAR;
            PG8_LDA(At, 0, 1); PG8_STAGE(PG8_SA(0, 0), a2, voffA);
            PG8_BAR; PG8_WAIT_L(0); PG8_MMA(1, 0, At, B0); PG8_BAR; PG8_SCHED;
            PG8_STAGE(PG8_SB(0, 1), b2 + hstep, voffB);
            PG8_WAIT_V(6); PG8_BAR; PG8_MMA(1, 1, At, B1); PG8_BAR;
            PG8_LDB(B0, 1, 0); PG8_SCHED; PG8_LDA(At, 1, 0); PG8_STAGE(PG8_SA(0, 1), a2 + hstep, voffA);
            PG8_WAIT_L(8); PG8_BAR; PG8_WAIT_L(0); PG8_MMA(0, 0, At, B0); PG8_BAR; PG8_SCHED;
            PG8_LDB(B1, 1, 1); PG8_STAGE(PG8_SB(1, 0), b3, voffB);
            PG8_BAR; PG8_WAIT_L(0); PG8_MMA(0, 1, At, B1); PG8_BAR;
            PG8_LDA(At, 1, 1); PG8_STAGE(PG8_SA(1, 0), a3, voffA);
            PG8_BAR; PG8_WAIT_L(0); PG8_MMA(1, 0, At, B0); PG8_BAR; PG8_SCHED;
            PG8_STAGE(PG8_SB(1, 1), b3 + hstep, voffB);
            PG8_WAIT_V(6); PG8_BAR; PG8_MMA(1, 1, At, B1); PG8_BAR;
            }
        }
        if constexpr (ALIGN_EPI) { if (wr == 0) PG8_BAR; }
        if (cur.slot >= 0) {
            const __amdgpu_buffer_rsrc_t rs = __builtin_amdgcn_make_buffer_rsrc((void*)(slab + (size_t)(S.c * 2 + cur.slot) * 262144), 0, 262144, 0x00020000);
#pragma unroll
            for (int a = 0; a < 2; ++a)
#pragma unroll
                for (int b = 0; b < 2; ++b)
#pragma unroll
                    for (int m = 0; m < 4; ++m)
#pragma unroll
                        for (int n = 0; n < 2; ++n) { const int j = ((a * 2 + b) * 4 + m) * 2 + n;
                            __builtin_amdgcn_raw_buffer_store_b128(__builtin_bit_cast(u32x4, acc[a][b][m][n]), rs, (unsigned)(tid * 16), j * 8192, 0); }
        } else {
            const Unit un{cur.pm, cur.pn, SAMP ? ((cur.pm & 1) ^ 1) : 0};
            if constexpr (SAMP) { SE(acc2, un, ui, wid, wr, wc, fr, fq, tid); acc2 = (f32x4){0.f, 0.f, 0.f, 0.f}; }
            E(acc, un, ui, wr, wc, fr, fq);
        }
        if (!has_next) break;
#pragma unroll
        for (int a = 0; a < 2; ++a)
#pragma unroll
            for (int b = 0; b < 2; ++b)
#pragma unroll
                for (int m = 0; m < 4; ++m)
#pragma unroll
                    for (int n = 0; n < 2; ++n) acc[a][b][m][n] = (f32x4){0.f, 0.f, 0.f, 0.f};
        cur = nxt; cA = nA; cB = nB; ++ui; if constexpr (SAMP) { cS = nS; cD = nD; }
        if constexpr (ALIGN_EPI) { if (wr == 1) PG8_BAR; }
    }
    PG8_WAIT_V(0);
    if constexpr (!ALIGN_EPI) { if (wr == 0) PG8_BAR; }
    PG8_BAR;
#undef PG8_SA
#undef PG8_SB
#undef PG8_STAGE
#undef PG8_LDA
#undef PG8_LDB
#undef PG8_MMA
#undef PG8_WAIT_V
#undef PG8_WAIT_VS
#undef PG8_SS
#undef PG8_STAGE_S
#undef PG8_LDS_S
#undef PG8_MS
#undef PG8_MMA_S
#undef PG8_WAIT_L
#undef PG8_BAR
#undef PG8_SCHED
}

typedef const f32x4 (&AccRef)[2][2][4][2];
struct EpiSwiGLU {
    static constexpr bool PERM = true;
    bf16* ACT; const LAS float* rtab;
    __device__ __forceinline__ void operator()(AccRef acc, const Unit& u, int ui, int wr, int wc, int fr, int fq) const {
        const int rl0 = wr * 64 + fr;
#pragma unroll
        for (int ai = 0; ai < 2; ++ai)
#pragma unroll
            for (int m = 0; m < 4; ++m) {
                const int rl = rl0 + ai * HALF + m * 16; const float r = rtab[(ui & 7) * 256 + rl];
                bf16* p = ACT + (size_t)(u.pm * BM + rl) * FF + u.pn * 128 + wc * 32 + 8 * fq;
                const float c = -r * LOG2E, rr = r * r; unsigned wv[4];
#pragma unroll
                for (int n = 0; n < 2; ++n)
#pragma unroll
                    for (int h2 = 0; h2 < 2; ++h2) { const f32x2 g2 = (f32x2){acc[ai][0][m][n][2 * h2], acc[ai][0][m][n][2 * h2 + 1]}, u2 = (f32x2){acc[ai][1][m][n][2 * h2], acc[ai][1][m][n][2 * h2 + 1]};
                        const f32x2 a2 = g2 * c; f32x2 e2; e2.x = __builtin_amdgcn_exp2f(a2.x); e2.y = __builtin_amdgcn_exp2f(a2.y);
                        const f32x2 d2 = e2 + 1.0f; f32x2 q2; q2.x = __builtin_amdgcn_rcpf(d2.x); q2.y = __builtin_amdgcn_rcpf(d2.y);
                        const f32x2 o2 = ((g2 * u2) * rr) * q2;
                        wv[n * 2 + h2] = cvt_pk_bf16(o2.x, o2.y); }
                u32x4 w; w.x = wv[0]; w.y = wv[1]; w.z = wv[2]; w.w = wv[3];
                *(u32x4*)p = w;
            }
    }
};
struct EpiResid {
    static constexpr bool PERM = true;
    bf16* XB; float* P; float alpha;
    __device__ __forceinline__ void rows(const f32x4 (&v)[2][2], const Unit& u, int ai, int m, int wr, int wc, int fr, int fq) const {
        const int row = u.pm * BM + wr * 64 + fr + ai * HALF + m * 16; const size_t off = (size_t)row * DM + u.pn * BM + wc * 32 + 8 * fq;
        float ss = 0.f;
#pragma unroll
        for (int bj = 0; bj < 2; ++bj) {
            const u32x4 xr = *(const u32x4*)(XB + off + (bj ^ u.sw) * HALF);
            const f32x4 x0 = (f32x4){bf2f(xr.x & 0xffffu), bf2f(xr.x >> 16), bf2f(xr.y & 0xffffu), bf2f(xr.y >> 16)}, x1 = (f32x4){bf2f(xr.z & 0xffffu), bf2f(xr.z >> 16), bf2f(xr.w & 0xffffu), bf2f(xr.w >> 16)};
            const f32x4 y0 = x0 + v[bj][0] * alpha, y1 = x1 + v[bj][1] * alpha;
            u32x4 w; w.x = cvt_pk_bf16(y0[0], y0[1]); w.y = cvt_pk_bf16(y0[2], y0[3]); w.z = cvt_pk_bf16(y1[0], y1[1]); w.w = cvt_pk_bf16(y1[2], y1[3]);
            *(u32x4*)(XB + off + (bj ^ u.sw) * HALF) = w;
            ss += (y0[0] * y0[0] + y0[1] * y0[1]) + (y0[2] * y0[2] + y0[3] * y0[3]) + (y1[0] * y1[0] + y1[1] * y1[1]) + (y1[2] * y1[2] + y1[3] * y1[3]);
        }
        ss += xor_get<16>(ss); ss = sum32(ss);
        if (fq == 0) P[(size_t)row * 32 + u.pn * 4 + wc] = ss;
    }
    __device__ __forceinline__ void operator()(AccRef acc, const Unit& u, int ui, int wr, int wc, int fr, int fq) const {
#pragma unroll
        for (int ai = 0; ai < 2; ++ai)
#pragma unroll
            for (int m = 0; m < 4; ++m) { const f32x4 v[2][2] = {{acc[ai][0][m][0], acc[ai][0][m][1]}, {acc[ai][1][m][0], acc[ai][1][m][1]}}; rows(v, u, ai, m, wr, wc, fr, fq); asm volatile("" ::: "memory"); }
    }
};
struct EpiGelu {
    static constexpr bool PERM = true;
    bf16* U; bf16* V; f32x2* S1; const LAS float* rtab;
    __device__ __forceinline__ void operator()(AccRef acc, const Unit& u, int ui, int wr, int wc, int fr, int fq) const {
        const int rl0 = wr * 64 + fr; const bool isv = u.pn >= 16; bf16* base = isv ? V : U; const int pc = u.pn & 15;
#pragma unroll
        for (int ai = 0; ai < 2; ++ai)
#pragma unroll
            for (int m = 0; m < 4; ++m) {
                const int rl = rl0 + ai * HALF + m * 16; const float r = rtab[(ui & 7) * 256 + rl]; const int row = u.pm * BM + rl;
                bf16* p = base + (size_t)row * DG + pc * BM + wc * 32 + 8 * fq;
                float s1 = 0.f, s2 = 0.f;
#pragma unroll
                for (int bj = 0; bj < 2; ++bj) {
                    const f32x4 v0 = acc[ai][bj][m][0] * r, v1 = acc[ai][bj][m][1] * r;
                    const f32x2 a = gelu_pk((f32x2){v0[0], v0[1]}), b = gelu_pk((f32x2){v0[2], v0[3]}), c = gelu_pk((f32x2){v1[0], v1[1]}), d = gelu_pk((f32x2){v1[2], v1[3]});
                    u32x4 w; w.x = cvt_pk_bf16(a.x, a.y); w.y = cvt_pk_bf16(b.x, b.y); w.z = cvt_pk_bf16(c.x, c.y); w.w = cvt_pk_bf16(d.x, d.y);
                    *(u32x4*)(p + (bj ^ u.sw) * HALF) = w;
                    s1 += (a.x + a.y) + (b.x + b.y) + (c.x + c.y) + (d.x + d.y);
                    s2 += (a.x * a.x + a.y * a.y) + (b.x * b.x + b.y * b.y) + (c.x * c.x + c.y * c.y) + (d.x * d.x + d.y * d.y);
                }
                if (isv) {
                    s1 += xor_get<16>(s1); s1 = sum32(s1); s2 += xor_get<16>(s2); s2 = sum32(s2);
                    if (fq == 0) S1[(size_t)row * 64 + pc * 4 + wc] = (f32x2){s1, s2};
                }
            }
    }
};
struct EpiQ {
    static constexpr bool PERM = true;
    bf16* O; const LAS float* rtab; const float* P;
    __device__ __forceinline__ void rows_r(const f32x4 (&v)[2][2], const Unit& u, float r, int ai, int m, int wr, int wc, int fr, int fq) const {
        const int rl = wr * 64 + fr + ai * HALF + m * 16;
        bf16* p = O + (size_t)(u.pm * BM + rl) * DM + u.pn * BM + wc * 32 + 8 * fq;
#pragma unroll
        for (int bj = 0; bj < 2; ++bj) {
            const f32x4 v0 = v[bj][0] * r, v1 = v[bj][1] * r;
            u32x4 w; w.x = cvt_pk_bf16(v0[0], v0[1]); w.y = cvt_pk_bf16(v0[2], v0[3]); w.z = cvt_pk_bf16(v1[0], v1[1]); w.w = cvt_pk_bf16(v1[2], v1[3]);
            *(u32x4*)(p + (bj ^ u.sw) * HALF) = w;
        }
    }
    __device__ __forceinline__ void rows(const f32x4 (&v)[2][2], const Unit& u, int ai, int m, int wr, int wc, int fr, int fq) const {
        const int row = u.pm * BM + wr * 64 + fr + ai * HALF + m * 16; const f32x4* p = (const f32x4*)(P + (size_t)row * 32); float s = 0.f;
#pragma unroll
        for (int i = 0; i < 8; ++i) { const f32x4 a = p[i]; s += (a[0] + a[1]) + (a[2] + a[3]); }
        rows_r(v, u, 1.0f / sqrtf(s * (1.0f / DM) + RMS_EPS), ai, m, wr, wc, fr, fq);
    }
    __device__ __forceinline__ void operator()(AccRef acc, const Unit& u, int ui, int wr, int wc, int fr, int fq) const {
#pragma unroll
        for (int ai = 0; ai < 2; ++ai)
#pragma unroll
            for (int m = 0; m < 4; ++m) { const f32x4 v[2][2] = {{acc[ai][0][m][0], acc[ai][0][m][1]}, {acc[ai][1][m][0], acc[ai][1][m][1]}};
                rows_r(v, u, rtab[(ui & 7) * 256 + wr * 64 + fr + ai * HALF + m * 16], ai, m, wr, wc, fr, fq); }
    }
};
struct EpiKV {
    static constexpr bool PERM = true;
    float* out; bf16* KB; bf16* VB; const LAS float* rtab;
    __device__ __forceinline__ void operator()(AccRef acc, const Unit& u, int ui, int wr, int wc, int fr, int fq) const {
        const int rl0 = wr * 64 + fr; const bool isv = u.pn >= 8; const int pc = u.pn & 7; const bool samp = u.pm >= SEQ / BM;
        float* fo = out + (samp ? (isv ? O_VS : O_KS) : (isv ? O_VP : O_KP)); bf16* bo = isv ? VB : KB;
#pragma unroll
        for (int ai = 0; ai < 2; ++ai)
#pragma unroll
            for (int m = 0; m < 4; ++m) {
                const int rl = rl0 + ai * HALF + m * 16; const float r = rtab[(ui & 7) * 256 + rl]; const int row = u.pm * BM + rl;
                const int col = pc * BM + wc * 32 + 8 * fq;
                float* fp = fo + (size_t)(samp ? row - SEQ : row) * DM + col; bf16* bp = bo + (size_t)row * DM + col;
#pragma unroll
                for (int bj = 0; bj < 2; ++bj) {
                    const f32x4 v0 = acc[ai][bj][m][0] * r, v1 = acc[ai][bj][m][1] * r;
                    *(f32x4*)(fp + bj * HALF) = v0; *(f32x4*)(fp + bj * HALF + 4) = v1;
                    u32x4 w; w.x = cvt_pk_bf16(v0[0], v0[1]); w.y = cvt_pk_bf16(v0[2], v0[3]); w.z = cvt_pk_bf16(v1[0], v1[1]); w.w = cvt_pk_bf16(v1[2], v1[3]);
                    *(u32x4*)(bp + bj * HALF) = w;
                }
            }
    }
};
__device__ __forceinline__ float row_rs(const float* P, int row) { const f32x4* p = (const f32x4*)(P + (size_t)row * 32); float s = 0.f;
#pragma unroll
    for (int i = 0; i < 8; ++i) { const f32x4 a = p[i]; s += (a[0] + a[1]) + (a[2] + a[3]); }
    return 1.0f / sqrtf(s * (1.0f / DM) + RMS_EPS); }
struct SEpiResid {
    static constexpr bool ON = true;
    bf16* XB; float* P; float alpha; LAS float* red;
    __device__ __forceinline__ void operator()(f32x4 v, const Unit& u, int ui, int wid, int wr, int wc, int fr, int fq, int tid) const {
        const int row0 = SEQ + 16 * (u.pm >> 1), col = u.pn * BM + (u.pm & 1) * HALF + wc * 32 + 8 * fq + 4 * wr;
        bf16* xp = XB + (size_t)(row0 + fr) * DM + col;
        const u32x2 xr = *(const u32x2*)xp;
        const f32x4 y = (f32x4){bf2f(xr.x & 0xffffu), bf2f(xr.x >> 16), bf2f(xr.y & 0xffffu), bf2f(xr.y >> 16)} + v * alpha;
        u32x2 w; w.x = cvt_pk_bf16(y[0], y[1]); w.y = cvt_pk_bf16(y[2], y[3]); *(u32x2*)xp = w;
        float ss = (y[0] * y[0] + y[1] * y[1]) + (y[2] * y[2] + y[3] * y[3]);
        ss += xor_get<16>(ss); ss = sum32(ss);
        if (fq == 0) red[wid * 16 + fr] = ss;
        LDS_WAIT(); __builtin_amdgcn_s_barrier(); asm volatile("" ::: "memory");
        if (tid < 32) { const int r = tid & 15, j = tid >> 4;
            const float s = (red[(2 * j) * 16 + r] + red[(2 * j + 1) * 16 + r]) + (red[(4 + 2 * j) * 16 + r] + red[(5 + 2 * j) * 16 + r]);
            P[(size_t)(row0 + r) * 32 + u.pn * 4 + (u.pm & 1) * 2 + j] = s; }
    }
};
struct SEpiQ {
    static constexpr bool ON = true;
    bf16* O; const LAS float* srt;
    __device__ __forceinline__ void operator()(f32x4 v, const Unit& u, int ui, int wid, int wr, int wc, int fr, int fq, int tid) const {
        const int row = SEQ + 16 * (u.pm >> 1) + fr, col = u.pn * BM + (u.pm & 1) * HALF + wc * 32 + 8 * fq + 4 * wr;
        const float r = srt[(ui & 7) * 16 + fr];
        u32x2 w; w.x = cvt_pk_bf16(v[0] * r, v[1] * r); w.y = cvt_pk_bf16(v[2] * r, v[3] * r); *(u32x2*)(O + (size_t)row * DM + col) = w;
    }
};
struct SEpiGelu {
    static constexpr bool ON = true;
    bf16* U; bf16* V; f32x2* S1; const LAS float* srt; LAS float* red;
    __device__ __forceinline__ void operator()(f32x4 v, const Unit& u, int ui, int wid, int wr, int wc, int fr, int fq, int tid) const {
        const bool isv = u.pn >= 16; const int pc = u.pn & 15;
        const int row0 = SEQ + 16 * (u.pm >> 1), col = pc * BM + (u.pm & 1) * HALF + wc * 32 + 8 * fq + 4 * wr;
        const float r = srt[(ui & 7) * 16 + fr];
        const f32x2 a = gelu_pk((f32x2){v[0] * r, v[1] * r}), b = gelu_pk((f32x2){v[2] * r, v[3] * r});
        u32x2 w; w.x = cvt_pk_bf16(a.x, a.y); w.y = cvt_pk_bf16(b.x, b.y); *(u32x2*)((isv ? V : U) + (size_t)(row0 + fr) * DG + col) = w;
        if (isv) {
            float s1 = (a.x + a.y) + (b.x + b.y), s2 = (a.x * a.x + a.y * a.y) + (b.x * b.x + b.y * b.y);
            s1 += xor_get<16>(s1); s1 = sum32(s1); s2 += xor_get<16>(s2); s2 = sum32(s2);
            if (fq == 0) { red[wid * 16 + fr] = s1; red[128 + wid * 16 + fr] = s2; }
            LDS_WAIT(); __builtin_amdgcn_s_barrier(); asm volatile("" ::: "memory");
            if (tid < 32) { const int rr = tid & 15, j = tid >> 4;
                const float t1 = (red[(2 * j) * 16 + rr] + red[(2 * j + 1) * 16 + rr]) + (red[(4 + 2 * j) * 16 + rr] + red[(5 + 2 * j) * 16 + rr]);
                const float t2 = (red[128 + (2 * j) * 16 + rr] + red[128 + (2 * j + 1) * 16 + rr]) + (red[128 + (4 + 2 * j) * 16 + rr] + red[128 + (5 + 2 * j) * 16 + rr]);
                S1[(size_t)(row0 + rr) * 64 + pc * 4 + (u.pm & 1) * 2 + j] = (f32x2){t1, t2}; }
        }
    }
};
}

#define XB_TMO      128
#define XB_XCNT(j)  (256  + 64 * (j))
#define XB_XSUB(j)  (1280 + 64 * (j))
#define XB_XGEN(j)  (2304 + 64 * (j))
#define XB_TOP      3328
#define XB_TOPGEN   3392
#define XCD_BAR_WORDS 3456
#define XB_SPIN_CAP (1u << 18)
__device__ __forceinline__ unsigned xb_ld(unsigned* p)              { return __hip_atomic_load(p, __ATOMIC_RELAXED, __HIP_MEMORY_SCOPE_AGENT); }
__device__ __forceinline__ unsigned xb_add(unsigned* p, unsigned v) { return __hip_atomic_fetch_add(p, v, __ATOMIC_RELAXED, __HIP_MEMORY_SCOPE_AGENT); }
__device__ __forceinline__ unsigned xb_xcc_id() { return (unsigned)__builtin_amdgcn_s_getreg((3 << 11) | 20) & 0xFu; }
#define XB_SPIN(cond, bar) do { unsigned _sp = 0; while (cond) { __builtin_amdgcn_s_sleep(1); \
    if ((++_sp & 255u) == 0u) { if (xb_ld(&(bar)[XB_TMO])) break; if (_sp > XB_SPIN_CAP) { atomicAdd(&(bar)[XB_TMO], 1u); break; } } } } while (0)
struct XcdBarrier { unsigned* bar; unsigned x; volatile LAS unsigned* st; };
__device__ __forceinline__ XcdBarrier xcd_barrier_post(unsigned* bar, volatile LAS unsigned* st) {
    XcdBarrier b; b.bar = bar; b.x = xb_xcc_id(); b.st = st;
    if (threadIdx.x == 0) (void)xb_add(&bar[XB_XCNT(b.x)], 1u);
    return b;
}
__device__ __forceinline__ void xcd_barrier_complete(unsigned* bar, unsigned x, unsigned& nloc, unsigned& nx) {
    const unsigned G = gridDim.x * gridDim.y * gridDim.z;
    unsigned sum, cnt, mine, sp = 0u;
    for (;;) {
        sum = 0u; cnt = 0u; mine = 0u;
#pragma unroll
        for (unsigned j = 0; j < 16; ++j) { const unsigned c = xb_ld(&bar[XB_XCNT(j)]); sum += c; cnt += (c > 0u) ? 1u : 0u; mine = (j == x) ? c : mine; }
        if (sum == G) break;
        __builtin_amdgcn_s_sleep(1);
        if ((++sp & 255u) == 0u) { if (xb_ld(&bar[XB_TMO])) break; if (sp > XB_SPIN_CAP) { atomicAdd(&bar[XB_TMO], 1u); break; } }
    }
    nloc = mine > 0u ? mine : 1u; nx = cnt > 0u ? cnt : 1u;
}
__device__ __forceinline__ void xcd_barrier(const XcdBarrier& b) {
    asm volatile("s_waitcnt vmcnt(0)" ::: "memory");
    __syncthreads();
    if (threadIdx.x == 0) {
        unsigned* bar = b.bar;
        __builtin_amdgcn_s_waitcnt(0);
        unsigned nloc = b.st[0], nx = b.st[1];
        if (nloc == 0u) { xcd_barrier_complete(bar, b.x, nloc, nx); b.st[0] = nloc; b.st[1] = nx; }
        const unsigned old = xb_add(&bar[XB_XSUB(b.x)], 1u);
        const unsigned gen = old / nloc;
        if (old + 1u == (gen + 1u) * nloc) {
            __builtin_amdgcn_fence(__ATOMIC_RELEASE, "agent");
            asm volatile("s_waitcnt vmcnt(0)" ::: "memory");
            const unsigned og = xb_add(&bar[XB_TOP], 1u);
            const unsigned tg = og / nx;
            if (og + 1u == (tg + 1u) * nx) xb_add(&bar[XB_TOPGEN], 1u);
            else XB_SPIN(xb_ld(&bar[XB_TOPGEN]) == tg, bar);
            __builtin_amdgcn_fence(__ATOMIC_ACQUIRE, "agent");
            xb_add(&bar[XB_XGEN(b.x)], 1u);
            asm volatile("s_waitcnt vmcnt(0)" ::: "memory");
        } else {
            XB_SPIN(xb_ld(&bar[XB_XGEN(b.x)]) == gen, bar);
            __builtin_amdgcn_fence(__ATOMIC_ACQUIRE, "agent");
            asm volatile("s_waitcnt vmcnt(0)" ::: "memory");
        }
    }
    __syncthreads();
}

struct Args { const float* in[28]; float* out; unsigned char* ws; int ph_lo, ph_hi; };
enum { I_XP = 0, I_XS, I_CK, I_CV, I_CLF, I_F1N, I_F1G, I_F1U, I_F1D, I_MIXN, I_F2N, I_F2G, I_F2U, I_F2D, I_WIN, I_LNG, I_LNB, I_WS, I_BS, I_WOUT, I_KVN, I_WK, I_WV, I_WF, I_BF, I_WQ, I_WO, I_FN };

__device__ __forceinline__ void tr_item(const float* W, int K, int N, const float* gain, float scale, bf16* WT, int mode, int row_off, LAS unsigned* scr, int item, int lane) {
    const int nblk = N / 128, grp = item >> 3, kb = 8 * (grp / nblk) + (item & 7), nb = grp % nblk, k0 = 64 * kb, n0 = 128 * nb;
    const int hl = lane >> 5, cl = lane & 31;
#pragma unroll 2
    for (int i0 = 0; i0 < 16; i0 += 8) {
        f32x4 ra[8], rb[8]; float ga[8], gb[8];
#pragma unroll
        for (int i = 0; i < 8; ++i) { const int kp = 2 * (i0 + i) + hl; const float* p = W + (size_t)(k0 + 2 * kp) * N + n0 + 4 * cl;
            ra[i] = __builtin_nontemporal_load((const GAS f32x4*)p); rb[i] = __builtin_nontemporal_load((const GAS f32x4*)(p + N));
            ga[i] = gain ? gain[k0 + 2 * kp] * scale : scale; gb[i] = gain ? gain[k0 + 2 * kp + 1] * scale : scale; }
#pragma unroll
        for (int i = 0; i < 8; ++i) { const int kp = 2 * (i0 + i) + hl;
            u32x4 w; w.x = cvt_pk_bf16(ra[i][0] * ga[i], rb[i][0] * gb[i]); w.y = cvt_pk_bf16(ra[i][1] * ga[i], rb[i][1] * gb[i]); w.z = cvt_pk_bf16(ra[i][2] * ga[i], rb[i][2] * gb[i]); w.w = cvt_pk_bf16(ra[i][3] * ga[i], rb[i][3] * gb[i]);
            *(LAS u32x4*)(scr + kp * 132 + 4 * cl) = w; }
    }
    LDS_WAIT(); asm volatile("" ::: "memory");
    const int c = lane & 7;
#pragma unroll 4
    for (int j = 0; j < 16; ++j) { const int n = (lane >> 3) + 8 * j; const LAS unsigned* sp = scr + (4 * c) * 132 + n;
        u32x4 o; o.x = sp[0]; o.y = sp[132]; o.z = sp[264]; o.w = sp[396];
        const int nn = n0 + n; const int drow = mode ? (256 * (nn >> 7) + row_off + (nn & 127)) : (row_off + nn);
        *(GAS u32x4*)(WT + (size_t)drow * K + k0 + 8 * c) = o; }
    LDS_WAIT(); asm volatile("" ::: "memory");
}
constexpr int IT_FFN = 1408, IT_WIN = 2048, IT_WOUT = 1024, IT_SQ = 512;
constexpr int IT_END_FFN = 24 * IT_FFN, IT_END_WIN = IT_END_FFN + 2 * IT_WIN, IT_END_WOUT = IT_END_WIN + 2 * IT_WOUT, IT_TOTAL = IT_END_WOUT + 6 * IT_SQ;
__device__ __forceinline__ void prologue(const Args& a, LAS unsigned char* lds, int vcu, int G, int wave, int lane) {
    unsigned char* ws = a.ws;
    LAS unsigned* scr = (LAS unsigned*)(lds + wave * 16896);
    const int gw = vcu * NWAVES + wave, NGW = G * NWAVES;
    for (int it_ = gw; it_ < IT_TOTAL; it_ += NGW) {
        const int it = IT_TOTAL - 1 - it_;
        if (it < IT_END_FFN) {
            const int j = it / IT_FFN, r = it - j * IT_FFN, hl = j / 3, t = j - hl * 3, l = hl >> 1, f = hl & 1;
            const float* nrm = a.in[f ? I_F2N : I_F1N] + (size_t)l * DM;
            if (t < 2) { const float* W = a.in[(f ? I_F2G : I_F1G) + t] + (size_t)l * DM * FF;
                tr_item(W, DM, FF, nrm, 1.0f, (bf16*)(ws + WS_WGU + (size_t)hl * SZ_WGU), 1, t * 128, scr, r, lane); }
            else { const float* W = a.in[f ? I_F2D : I_F1D] + (size_t)l * FF * DM;
                tr_item(W, FF, DM, nullptr, 1.0f, (bf16*)(ws + WS_WD + (size_t)hl * SZ_WD), 0, 0, scr, r, lane); }
        } else if (it < IT_END_WIN) {
            const int q = it - IT_END_FFN, l = q / IT_WIN, r = q - l * IT_WIN;
            tr_item(a.in[I_WIN] + (size_t)l * DM * 2 * DG, DM, 2 * DG, a.in[I_MIXN] + (size_t)l * DM, 1.0f, (bf16*)(ws + WS_WIN + (size_t)l * SZ_WIN), 0, 0, scr, r, lane);
        } else if (it < IT_END_WOUT) {
            const int q = it - IT_END_WIN, l = q / IT_WOUT, r = q - l * IT_WOUT;
            tr_item(a.in[I_WOUT] + (size_t)l * DG * DM, DG, DM, nullptr, 1.0f, (bf16*)(ws + WS_WOUT + (size_t)l * SZ_WOUT), 0, 0, scr, r, lane);
        } else {
            const int q = it - IT_END_WOUT, j = q / IT_SQ, r = q - j * IT_SQ;
            if (j < 2) tr_item(a.in[I_WK + j], DM, DM, a.in[I_KVN], 1.0f, (bf16*)(ws + WS_WKV), 0, j * DM, scr, r, lane);
            else if (j < 4) tr_item(a.in[I_WQ] + (size_t)(j - 2) * DM * DM, DM, DM, a.in[I_MIXN] + (size_t)(2 + j - 2) * DM, 0.08838834764831845f * LOG2E, (bf16*)(ws + WS_WQ + (size_t)(j - 2) * SZ_WQ), 0, 0, scr, r, lane);
            else tr_item(a.in[I_WO] + (size_t)(j - 4) * DM * DM, DM, DM, nullptr, 1.0f, (bf16*)(ws + WS_WO + (size_t)(j - 4) * SZ_WQ), 0, 0, scr, r, lane);
        }
    }
    bf16* XB = (bf16*)(ws + WS_XB); float* P = (float*)(ws + WS_P);
    { f32x4 xv[8]; int m = gw;
      if (m < M) { const float* src = m < SEQ ? a.in[I_XP] + (size_t)m * DM : a.in[I_XS] + (size_t)(m - SEQ) * DM;
#pragma unroll
          for (int j = 0; j < 8; ++j) xv[j] = *(const GAS f32x4*)(src + 256 * j + 4 * lane); }
      while (m < M) {
        const int mn = m + NGW; f32x4 xn[8];
#pragma unroll
        for (int j = 0; j < 8; ++j) xn[j] = xv[j];
        if (mn < M) { const float* src = mn < SEQ ? a.in[I_XP] + (size_t)mn * DM : a.in[I_XS] + (size_t)(mn - SEQ) * DM;
#pragma unroll
            for (int j = 0; j < 8; ++j) xn[j] = *(const GAS f32x4*)(src + 256 * j + 4 * lane); }
        float ss = 0.f;
#pragma unroll
        for (int j = 0; j < 8; ++j) { const f32x4 v = xv[j];
            u32x2 w; w.x = cvt_pk_bf16(v[0], v[1]); w.y = cvt_pk_bf16(v[2], v[3]); *(GAS u32x2*)(XB + (size_t)m * DM + 256 * j + 4 * lane) = w;
            ss += (v[0] * v[0] + v[1] * v[1]) + (v[2] * v[2] + v[3] * v[3]); }
        ss = wave_sum(ss);
        if (lane < 32) P[(size_t)m * 32 + lane] = lane == 0 ? ss : 0.f;
#pragma unroll
        for (int j = 0; j < 8; ++j) xv[j] = xn[j];
        m = mn;
      } }
    if (vcu < DEC_B) {
        const int tid = wave * 64 + lane, b = vcu, h = tid & 15, c = tid >> 4;
        const float* src = a.in[I_CLF] + ((size_t)b * PAST + (size_t)c * 64) * NH + h;
        LAS float* tots = (LAS float*)lds;
        float tot = 0.f;
#pragma unroll 1
        for (int s0 = 0; s0 < 64; s0 += 16) { float v[16];
#pragma unroll
            for (int i = 0; i < 16; ++i) v[i] = src[(size_t)(s0 + i) * NH];
#pragma unroll
            for (int i = 0; i < 16; ++i) tot += v[i]; }
        __syncthreads();
        tots[c * 16 + h] = tot;
        __syncthreads();
        float run = 0.f;
        for (int cc = 0; cc < c; ++cc) run += tots[cc * 16 + h];
        float* dst = (float*)(ws + WS_CKS) + (size_t)(b * NH + h) * CKS_STRIDE + c * 64;
#pragma unroll 1
        for (int s0 = 0; s0 < 64; s0 += 16) { float v[16];
#pragma unroll
            for (int i = 0; i < 16; ++i) v[i] = src[(size_t)(s0 + i) * NH];
#pragma unroll
            for (int i = 0; i < 16; ++i) { run += v[i]; dst[s0 + i] = -run * LOG2E; } }
        if (c == 31) ((float*)(ws + WS_CEND))[b * NH + h] = run;
    }
}

__device__ __forceinline__ void build_rtab(LAS float* rtab, const float* P, const pg8::HybridOrder& S, int tid) {
    asm volatile("" : "+v"(tid));
#pragma unroll 1
    for (int i = 0; i < 8; ++i) { pg8::Seg u; if (!S.seg(i, u)) break;
        const int row = u.pm * 256 + (tid >> 1); const f32x4* p = (const f32x4*)(P + (size_t)row * 32 + (tid & 1) * 16);
        const f32x4 a = p[0], b = p[1], c = p[2], d = p[3];
        float s = ((a[0] + a[1]) + (a[2] + a[3])) + ((b[0] + b[1]) + (b[2] + b[3])) + ((c[0] + c[1]) + (c[2] + c[3])) + ((d[0] + d[1]) + (d[2] + d[3]));
        s += xor_get<1>(s);
        if ((tid & 1) == 0) rtab[i * 256 + (tid >> 1)] = 1.0f / sqrtf(s * (1.0f / DM) + RMS_EPS); }
    __syncthreads();
}
__device__ __forceinline__ void build_srt(LAS float* srt, const float* P, const pg8::HybridOrder& S, int tid) {
    asm volatile("" : "+v"(tid));
    if (tid < 256) { const int i = tid >> 5, t = tid & 31; pg8::Seg u;
        if (S.seg(i, u)) { const int row = SEQ + 16 * (u.pm >> 1) + (t >> 1); const f32x4* p = (const f32x4*)(P + (size_t)row * 32 + (t & 1) * 16);
            const f32x4 a = p[0], b = p[1], c = p[2], d = p[3];
            float s = ((a[0] + a[1]) + (a[2] + a[3])) + ((b[0] + b[1]) + (b[2] + b[3])) + ((c[0] + c[1]) + (c[2] + c[3])) + ((d[0] + d[1]) + (d[2] + d[3]));
            s += xor_get<1>(s);
            if ((t & 1) == 0) srt[i * 16 + (t >> 1)] = 1.0f / sqrtf(s * (1.0f / DM) + RMS_EPS); } }
    __syncthreads();
}
template <class Epi>
__device__ __forceinline__ void fixup(const pg8::HybridOrder& S, const Epi& E, const unsigned char* slab, int tid) {
    if (!S.split) return;
    asm volatile("" : "+v"(tid));
    const int wid = __builtin_amdgcn_readfirstlane(tid >> 6), lane = tid & 63, wr = wid >> 2, wc = wid & 3, fr = lane & 15, fq = lane >> 4;
    const long W = (long)S.R * S.T;
    for (int item = S.c; item < S.R * 8; item += S.G) {
        const int r = item >> 3, ai = (item >> 2) & 1, m = item & 3;
        pg8::Unit u; u.sw = 0; S.decode(S.q * S.G + r, u.pm, u.pn);
        f32x4 v[2][2] = {{(f32x4){0.f, 0.f, 0.f, 0.f}, (f32x4){0.f, 0.f, 0.f, 0.f}}, {(f32x4){0.f, 0.f, 0.f, 0.f}, (f32x4){0.f, 0.f, 0.f, 0.f}}};
        const int ulo = r * S.T, uhi = ulo + S.T;
        int v0 = (int)(((long)ulo * S.G) / W) - 1; if (v0 < 0) v0 = 0;
#pragma unroll 1
        for (int vv = v0; vv < S.G; ++vv) {
            const int lov = (int)((long)vv * W / S.G), hiv = (int)((long)(vv + 1) * W / S.G);
            if (lov >= uhi) break;
            if (hiv <= ulo || hiv <= lov) continue;
            const int slot = r - lov / S.T;
            const unsigned char* base = slab + (size_t)(vv * 2 + slot) * 262144 + (size_t)tid * 16;
#pragma unroll
            for (int bj = 0; bj < 2; ++bj)
#pragma unroll
                for (int n = 0; n < 2; ++n) { const int j = ((ai * 2 + bj) * 4 + m) * 2 + n; v[bj][n] += *(const f32x4*)(base + (size_t)j * 8192); }
        }
        E.rows(v, u, ai, m, wr, wc, fr, fq);
    }
}

__device__ __forceinline__ f32x4 mini_tile(const bf16* A, const bf16* Bt, int K, LAS unsigned char* lds, int tid) {
    asm volatile("" : "+v"(tid));
    const int wid = __builtin_amdgcn_readfirstlane(tid >> 6), lane = tid & 63, r16 = lane & 15, kg = lane >> 4;
    const int kw = K >> 3, nb = kw >> 6;
    const bf16* ap = A + (size_t)r16 * K + wid * kw + 8 * kg;
    const bf16* bp = Bt + (size_t)r16 * K + wid * kw + 8 * kg;
    f32x4 acc[2][4];
#pragma unroll
    for (int m = 0; m < 2; ++m)
#pragma unroll
        for (int n = 0; n < 4; ++n) acc[m][n] = (f32x4){0.f, 0.f, 0.f, 0.f};
    bf16x8 a0[2][2], b0[4][2], a1[2][2], b1[4][2], a2[2][2], b2[4][2];
#define MT_LOAD(a_, b_, kk) do { _Pragma("unroll") for (int s_ = 0; s_ < 2; ++s_) { _Pragma("unroll") for (int m_ = 0; m_ < 2; ++m_) a_[m_][s_] = *(const bf16x8*)(ap + (size_t)m_ * 16 * K + (kk) + 32 * s_); \
        _Pragma("unroll") for (int n_ = 0; n_ < 4; ++n_) b_[n_][s_] = *(const bf16x8*)(bp + (size_t)n_ * 16 * K + (kk) + 32 * s_); } } while (0)
#define MT_MMA(a_, b_) do { _Pragma("unroll") for (int s_ = 0; s_ < 2; ++s_) _Pragma("unroll") for (int m_ = 0; m_ < 2; ++m_) _Pragma("unroll") for (int n_ = 0; n_ < 4; ++n_) \
        acc[m_][n_] = __builtin_amdgcn_mfma_f32_16x16x32_bf16(a_[m_][s_], b_[n_][s_], acc[m_][n_], 0, 0, 0); } while (0)
    MT_LOAD(a0, b0, 0);
    if (nb > 1) MT_LOAD(a1, b1, 64);
    for (int i = 0; i < nb; i += 3) {
        if (i + 2 < nb) MT_LOAD(a2, b2, (i + 2) * 64);
        MT_MMA(a0, b0);
        if (i + 3 < nb) MT_LOAD(a0, b0, (i + 3) * 64);
        if (i + 1 < nb) MT_MMA(a1, b1);
        if (i + 4 < nb) MT_LOAD(a1, b1, (i + 4) * 64);
        if (i + 2 < nb) MT_MMA(a2, b2);
    }
#undef MT_LOAD
#undef MT_MMA
    LAS float* part = (LAS float*)lds;
    __syncthreads();
#pragma unroll
    for (int m = 0; m < 2; ++m)
#pragma unroll
        for (int n = 0; n < 4; ++n)
#pragma unroll
            for (int rg = 0; rg < 4; ++rg) part[(wid * 32 + 16 * m + 4 * kg + rg) * 68 + 16 * n + r16] = acc[m][n][rg];
    __syncthreads();
    const int rloc = tid >> 4, c4 = (tid & 15) * 4;
    f32x4 v = (f32x4){0.f, 0.f, 0.f, 0.f};
#pragma unroll
    for (int w = 0; w < 8; ++w) v += *(const LAS f32x4*)(part + (w * 32 + rloc) * 68 + c4);
    __syncthreads();
    return v;
}
__device__ __forceinline__ void mini_resid(const bf16* A, const bf16* Bt, int K, bf16* XB, float* P, float alpha, LAS unsigned char* lds, int c, int tid) {
    const int rgp = c >> 5, cg = c & 31;
    const f32x4 v = mini_tile(A + (size_t)(SEQ + 32 * rgp) * K, Bt + (size_t)(64 * cg) * K, K, lds, tid);
    const int row = SEQ + 32 * rgp + (tid >> 4), col = 64 * cg + (tid & 15) * 4;
    bf16* xp = XB + (size_t)row * DM + col;
    const u32x2 xr = *(const u32x2*)xp;
    const f32x4 y = (f32x4){bf2f(xr.x & 0xffffu), bf2f(xr.x >> 16), bf2f(xr.y & 0xffffu), bf2f(xr.y >> 16)} + v * alpha;
    u32x2 w; w.x = cvt_pk_bf16(y[0], y[1]); w.y = cvt_pk_bf16(y[2], y[3]); *(u32x2*)xp = w;
    float ss = (y[0] * y[0] + y[1] * y[1]) + (y[2] * y[2] + y[3] * y[3]);
    ss += xor_get<1>(ss); ss += xor_get<2>(ss); ss += xor_get<4>(ss); ss += xor_get<8>(ss);
    if ((tid & 15) == 0) P[(size_t)row * 32 + cg] = ss;
}
__device__ __forceinline__ void mini_q(const bf16* A, const bf16* Bt, int K, bf16* Q, const float* P, LAS unsigned char* lds, int c, int tid) {
    const int rgp = c >> 5, cg = c & 31;
    const f32x4 v = mini_tile(A + (size_t)(SEQ + 32 * rgp) * K, Bt + (size_t)(64 * cg) * K, K, lds, tid);
    const int row = SEQ + 32 * rgp + (tid >> 4), col = 64 * cg + (tid & 15) * 4;
    const f32x4* p = (const f32x4*)(P + (size_t)row * 32); float s = 0.f;
#pragma unroll
    for (int i = 0; i < 8; ++i) { const f32x4 a = p[i]; s += (a[0] + a[1]) + (a[2] + a[3]); }
    const float r = 1.0f / sqrtf(s * (1.0f / DM) + RMS_EPS);
    u32x2 w; w.x = cvt_pk_bf16(v[0] * r, v[1] * r); w.y = cvt_pk_bf16(v[2] * r, v[3] * r); *(u32x2*)(Q + (size_t)row * DM + col) = w;
}

__device__ __forceinline__ int v_st(int k, int c) { const int kk = (k & ~0xC) | ((k & 4) << 1) | ((k & 8) >> 1); return ((kk >> 3) * 4 + (c >> 5)) * 512 + ((kk & 7) * 32 + (c & 31)) * 2; }
__device__ __forceinline__ int v_rd_base(int lane) { return ((lane & 3) << 3) | (((lane >> 2) & 3) << 6) | (((lane >> 4) & 1) << 5) | (((lane >> 5) & 1) << 8); }
constexpr int v_rd_off(int d0, int ks, int half) { return d0 * 512 + ks * 4096 + half * 2048; }
__device__ __forceinline__ int crow(int r, int hi) { return (r & 3) + 8 * (r >> 2) + 4 * hi; }
#define TRRD(dst, base, off) asm volatile("ds_read_b64_tr_b16 %0, %1 offset:%2" : "=&v"(dst) : "v"(base), "i"(off) : "memory")
template <int TILE_OFF>
__device__ __forceinline__ void mix_tile(f32x16* o, int vb0, bf16x8 pa0, bf16x8 pa1, bf16x8 pa2, bf16x8 pa3) {
#define MX_D0(d0) do { s16x4 l0, l1, l2, l3, h0, h1, h2, h3; constexpr int b_ = TILE_OFF + v_rd_off(d0, 0, 0); \
        TRRD(l0, vb0, b_); TRRD(h0, vb0, b_ + 2048); TRRD(l1, vb0, b_ + 4096); TRRD(h1, vb0, b_ + 6144); TRRD(l2, vb0, b_ + 8192); TRRD(h2, vb0, b_ + 10240); TRRD(l3, vb0, b_ + 12288); TRRD(h3, vb0, b_ + 14336); \
        asm volatile("s_waitcnt lgkmcnt(0)" ::: "memory"); __builtin_amdgcn_sched_barrier(0); \
        o[d0] = __builtin_amdgcn_mfma_f32_32x32x16_bf16((bf16x8){l0[0], l0[1], l0[2], l0[3], h0[0], h0[1], h0[2], h0[3]}, pa0, o[d0], 0, 0, 0); \
        o[d0] = __builtin_amdgcn_mfma_f32_32x32x16_bf16((bf16x8){l1[0], l1[1], l1[2], l1[3], h1[0], h1[1], h1[2], h1[3]}, pa1, o[d0], 0, 0, 0); \
        o[d0] = __builtin_amdgcn_mfma_f32_32x32x16_bf16((bf16x8){l2[0], l2[1], l2[2], l2[3], h2[0], h2[1], h2[2], h2[3]}, pa2, o[d0], 0, 0, 0); \
        o[d0] = __builtin_amdgcn_mfma_f32_32x32x16_bf16((bf16x8){l3[0], l3[1], l3[2], l3[3], h3[0], h3[1], h3[2], h3[3]}, pa3, o[d0], 0, 0, 0); } while (0)
    MX_D0(0); MX_D0(1); MX_D0(2); MX_D0(3);
#undef MX_D0
}
__device__ __forceinline__ void mix_unit(const Args& a, LAS unsigned char* lds, int l, int row0, int nrows, int g, float* gv_out  , int tid) {
    int z = 0; asm volatile("" : "+s"(z));
    unsigned char* ws = a.ws + z;
    const bf16* U = (const bf16*)(ws + WS_U); const bf16* V = (const bf16*)(ws + WS_V); bf16* Gt = (bf16*)(ws + WS_G); const f32x2* S1 = (const f32x2*)(ws + WS_S1);
    const float* w_s = a.in[I_WS + z] + ((size_t)l * 4 + g) * 128 * 128; const float* b_s = a.in[I_BS + z] + ((size_t)l * 4 + g) * 128;
    const float* lng = a.in[I_LNG + z] + (size_t)l * DG + g * 1024; const float* lnb = a.in[I_LNB + z] + (size_t)l * DG + g * 1024;
    asm volatile("" : "+v"(tid));
    const int wid = __builtin_amdgcn_readfirstlane(tid >> 6), lane = tid & 63, r32 = lane & 31, hi = lane >> 5;
    const int tb = wid & 3, ct = wid >> 2;
    LAS f32x2* stat = (LAS f32x2*)(lds + 65536); LAS float* lnp = (LAS float*)(lds + 66560);
    __syncthreads();
    { const int row = tid >> 2, qd = tid & 3; float s1 = 0.f, s2 = 0.f;
      if (row < nrows) { const f32x4* p = (const f32x4*)(S1 + (size_t)(row0 + row) * 64 + qd * 16);
#pragma unroll
          for (int i = 0; i < 8; ++i) { const f32x4 v = p[i]; s1 += v[0] + v[2]; s2 += v[1] + v[3]; } }
      s1 += xor_get<1>(s1); s1 += xor_get<2>(s1); s2 += xor_get<1>(s2); s2 += xor_get<2>(s2);
      if (qd == 0) { const float mean = s1 * (1.0f / DG); const float var = fmaxf(s2 * (1.0f / DG) - mean * mean, 0.f); stat[row] = (f32x2){mean, 1.0f / sqrtf(var + LN_EPS)}; } }
    const int t = 32 * tb + r32;
    bf16x8 pa[2][4];
#pragma unroll
    for (int st = 0; st < 2; ++st)
#pragma unroll
        for (int ks = 0; ks < 4; ++ks) { const int s0 = 64 * st + 16 * ks + 8 * hi; f32x4 w0 = (f32x4){0.f, 0.f, 0.f, 0.f}, w1 = w0;
            if (t < nrows && s0 <= t) { w0 = *(const f32x4*)(w_s + (size_t)t * 128 + s0); w1 = *(const f32x4*)(w_s + (size_t)t * 128 + s0 + 4); }
            float w[8] = {w0[0], w0[1], w0[2], w0[3], w1[0], w1[1], w1[2], w1[3]};
#pragma unroll
            for (int j = 0; j < 8; ++j) if (s0 + j > t || s0 + j >= nrows) w[j] = 0.f;
            u32x4 pk; pk.x = cvt_pk_bf16(w[0], w[1]); pk.y = cvt_pk_bf16(w[2], w[3]); pk.z = cvt_pk_bf16(w[4], w[5]); pk.w = cvt_pk_bf16(w[6], w[7]);
            pa[st][ks] = __builtin_bit_cast(bf16x8, pk); }
    const float bias = t < nrows ? b_s[t] : 0.f;
    const int nst = nrows > 64 ? 2 : 1;
    const int vb0 = (int)(uintptr_t)(lds) + v_rd_base(lane) + ct * 16384;
    const int sr = tid >> 4, sc = (tid & 15) * 8;
    u32x4 raw[2][2][2];
#define MIX_LOADV(slab_) do { const int cb_ = g * 1024 + (slab_) * 256; _Pragma("unroll") for (int st = 0; st < 2; ++st) _Pragma("unroll") for (int c2 = 0; c2 < 2; ++c2) _Pragma("unroll") for (int hh = 0; hh < 2; ++hh) { \
        const int s_ = 64 * st + 32 * hh + sr; raw[st][c2][hh] = (u32x4){0u, 0u, 0u, 0u}; if (st < nst && s_ < nrows) raw[st][c2][hh] = *(const u32x4*)(V + (size_t)(row0 + s_) * DG + cb_ + c2 * 128 + sc); } } while (0)
    MIX_LOADV(0);
    float lg_n = 0.f, lb_n = 0.f;
    if (tid < 256) { lg_n = lng[tid]; lb_n = lnb[tid]; }
    for (int slab = 0; slab < 4; ++slab) {
        const int cb = g * 1024 + slab * 256;
        if (tid < 256) { lnp[tid] = lg_n; lnp[256 + tid] = lb_n; }
        __syncthreads();
#pragma unroll
        for (int st = 0; st < 2; ++st)
#pragma unroll
            for (int c2 = 0; c2 < 2; ++c2)
#pragma unroll
                for (int hh = 0; hh < 2; ++hh) {
                    const int s = 64 * st + 32 * hh + sr; u32x4 pk = (u32x4){0u, 0u, 0u, 0u};
                    if (st < nst && s < nrows) {
                        const f32x2 ms = stat[s]; float vn[8];
                        const unsigned rw[4] = {raw[st][c2][hh].x, raw[st][c2][hh].y, raw[st][c2][hh].z, raw[st][c2][hh].w};
#pragma unroll
                        for (int j = 0; j < 4; ++j) { const int cc = c2 * 128 + sc + 2 * j;
                            vn[2 * j] = (bf2f(rw[j] & 0xffffu) - ms.x) * ms.y * lnp[cc] + lnp[256 + cc];
                            vn[2 * j + 1] = (bf2f(rw[j] >> 16) - ms.x) * ms.y * lnp[cc + 1] + lnp[256 + cc + 1]; }
                        pk.x = cvt_pk_bf16(vn[0], vn[1]); pk.y = cvt_pk_bf16(vn[2], vn[3]); pk.z = cvt_pk_bf16(vn[4], vn[5]); pk.w = cvt_pk_bf16(vn[6], vn[7]);
                        if (gv_out) { float* gp = gv_out + (size_t)s * DG + cb + c2 * 128 + sc; *(f32x4*)gp = (f32x4){vn[0], vn[1], vn[2], vn[3]}; *(f32x4*)(gp + 4) = (f32x4){vn[4], vn[5], vn[6], vn[7]}; }
                    }
                    if (st < nst) *(LAS u32x4*)(lds + (st * 2 + c2) * 16384 + v_st(32 * hh + sr, sc)) = pk;
                }
        if (slab + 1 < 4) MIX_LOADV(slab + 1);
        __syncthreads();
        f32x16 o[4];
#pragma unroll
        for (int d0 = 0; d0 < 4; ++d0) o[d0] = (f32x16){0.f, 0.f, 0.f, 0.f, 0.f, 0.f, 0.f, 0.f, 0.f, 0.f, 0.f, 0.f, 0.f, 0.f, 0.f, 0.f};
        if (32 * tb < nrows) {
            mix_tile<0>(o, vb0, pa[0][0], pa[0][1], pa[0][2], pa[0][3]);
            if (tb >= 2) mix_tile<32768>(o, vb0, pa[1][0], pa[1][1], pa[1][2], pa[1][3]);
        }
        { LAS unsigned char* wt = lds + 69632 + wid * 8704;
#pragma unroll
          for (int d0 = 0; d0 < 4; ++d0)
#pragma unroll
              for (int rq = 0; rq < 4; ++rq) { u32x2 w; w.x = cvt_pk_bf16(o[d0][4 * rq + 0] + bias, o[d0][4 * rq + 1] + bias); w.y = cvt_pk_bf16(o[d0][4 * rq + 2] + bias, o[d0][4 * rq + 3] + bias);
                  *(LAS u32x2*)(wt + r32 * 272 + (d0 * 32 + 8 * rq + 4 * hi) * 2) = w; }
          asm volatile("s_waitcnt lgkmcnt(0)" ::: "memory");
          const int rr = lane >> 4, ch = lane & 15;
          u32x4 uq[8];
#pragma unroll
          for (int it = 0; it < 8; ++it) { const int tt = 32 * tb + rr + 4 * it; uq[it] = (u32x4){0u, 0u, 0u, 0u};
              if (tt < nrows) uq[it] = *(const u32x4*)(U + (size_t)(row0 + tt) * DG + cb + ct * 128 + ch * 8); }
          if (slab + 1 < 4 && tid < 256) { lg_n = lng[(slab + 1) * 256 + tid]; lb_n = lnb[(slab + 1) * 256 + tid]; }
#pragma unroll
          for (int it = 0; it < 8; ++it) { const int rl = rr + 4 * it, tt = 32 * tb + rl;
              if (tt < nrows) { const size_t off = (size_t)(row0 + tt) * DG + cb + ct * 128 + ch * 8;
                  const u32x4 mx = *(const LAS u32x4*)(wt + rl * 272 + ch * 16); const u32x4 uu = uq[it];
                  const unsigned mw[4] = {mx.x, mx.y, mx.z, mx.w}, uw[4] = {uu.x, uu.y, uu.z, uu.w}; u32x4 gw; unsigned gg[4];
#pragma unroll
                  for (int j = 0; j < 4; ++j) gg[j] = cvt_pk_bf16(bf2f(uw[j] & 0xffffu) * bf2f(mw[j] & 0xffffu), bf2f(uw[j] >> 16) * bf2f(mw[j] >> 16));
                  gw.x = gg[0]; gw.y = gg[1]; gw.z = gg[2]; gw.w = gg[3]; *(u32x4*)(Gt + off) = gw; } }
          asm volatile("s_waitcnt lgkmcnt(0)" ::: "memory"); }
    }
}

#undef MIX_LOADV
namespace fa {
constexpr int D = 128, PITCH = DM, NW = 8, QBLK = 32, KVBLK = 64, QB = NW * QBLK;
constexpr int SHM_V = KVBLK * D * 2, SHM_K = KVBLK * D * 2;
constexpr int OFF_WS = 2 * SHM_V + 2 * SHM_K, OFF_KX = OFF_WS + NW * 64 * 4, LDS_NEED = OFF_KX + 2 * 256;
constexpr float THR = 8.f;
#define KSWZ(row, colB) ((row) * 256 + ((colB) ^ (((row) & 7) << 4)))
#define SBAR() __builtin_amdgcn_sched_barrier(0)
__device__ __forceinline__ void mask_tile(f32x16& p0, f32x16& p1, int dq, unsigned W) {
    const float NEG = -__builtin_inff();
#pragma unroll
    for (int r = 0; r < 16; ++r) {
        const int c = (r & 3) + 8 * (r >> 2);
        if ((unsigned)(dq - c) >= W) p0[r] = NEG;
        if ((unsigned)(dq - c - 32) >= W) p1[r] = NEG;
    }
}
__device__ __forceinline__ void partialSM(f32x16& p0, f32x16& p1, float& m_reg, float& mn, float& alpha) {
    float pmax = p0[0]; for (int r = 1; r < 16; ++r) pmax = fmaxf(pmax, p0[r]); for (int r = 0; r < 16; ++r) pmax = fmaxf(pmax, p1[r]);
    { auto rr = __builtin_amdgcn_permlane32_swap(__float_as_uint(pmax), __float_as_uint(pmax), false, false);
      pmax = fmaxf(__uint_as_float(rr[0]), __uint_as_float(rr[1])); }
    if (__builtin_expect(__all((pmax - m_reg) * LN2 <= THR), 1)) { mn = m_reg; alpha = 1.f; }
    else { mn = fmaxf(m_reg, pmax); alpha = __builtin_amdgcn_exp2f(m_reg - mn); m_reg = mn; }
    for (int r = 0; r < 16; ++r) p0[r] = p0[r] - mn; for (int r = 0; r < 16; ++r) p1[r] = p1[r] - mn;
    for (int r = 0; r < 16; ++r) p0[r] = __builtin_amdgcn_exp2f(p0[r]);
}
__device__ __forceinline__ void finishSM(f32x16& p0, f32x16& p1, float alpha, float& l_reg, bf16x8& pa0, bf16x8& pa1, bf16x8& pa2, bf16x8& pa3) {
    for (int r = 0; r < 16; ++r) p1[r] = __builtin_amdgcn_exp2f(p1[r]);
    float ps = 0; for (int r = 0; r < 16; ++r) ps += p0[r]; for (int r = 0; r < 16; ++r) ps += p1[r];
    { auto rr = __builtin_amdgcn_permlane32_swap(__float_as_uint(ps), __float_as_uint(ps), false, false);
      ps = __uint_as_float(rr[0]) + __uint_as_float(rr[1]); }
    l_reg = l_reg * alpha + ps;
#define PK4(P, B_, OUT) do { unsigned a0 = cvt_pk_bf16(P[B_+0], P[B_+1]), a1 = cvt_pk_bf16(P[B_+2], P[B_+3]);                          \
        unsigned b0 = cvt_pk_bf16(P[B_+4], P[B_+5]), b1 = cvt_pk_bf16(P[B_+6], P[B_+7]);                                             \
        auto r0 = __builtin_amdgcn_permlane32_swap(a0, b0, false, false); auto r1 = __builtin_amdgcn_permlane32_swap(a1, b1, false, false); \
        u32x4 w = {r0[0], r1[0], r0[1], r1[1]}; OUT = *reinterpret_cast<bf16x8*>(&w); } while (0)
    PK4(p0, 0, pa0); PK4(p0, 8, pa1); PK4(p1, 0, pa2); PK4(p1, 8, pa3);
#undef PK4
}
template <int KB>
__device__ __forceinline__ void qkt(f32x16& p0, f32x16& p1, const char* K_lds, int r32, int hi, const bf16x8* qr) {
    p0 = f32x16{}; p1 = f32x16{};
    const char* kb[4];
#pragma unroll
    for (int dd = 0; dd < 4; ++dd) kb[dd] = K_lds + KB * SHM_K + KSWZ(r32, (dd * 16 + hi * 8) * 2);
#pragma unroll
    for (int d0 = 0; d0 < 8; ++d0) { const char* a = kb[d0 & 3] + (d0 >> 2) * 128;
        bf16x8 b0 = *reinterpret_cast<const bf16x8*>(a);
        bf16x8 b1 = *reinterpret_cast<const bf16x8*>(a + 32 * 256);
        p0 = __builtin_amdgcn_mfma_f32_32x32x16_bf16(b0, qr[d0], p0, 0, 0, 0);
        p1 = __builtin_amdgcn_mfma_f32_32x32x16_bf16(b1, qr[d0], p1, 0, 0, 0); }
}
template <int VB>
__device__ __forceinline__ void pv_tile(f32x16* o, int vb0, bf16x8 pa0, bf16x8 pa1, bf16x8 pa2, bf16x8 pa3) {
#define PV_D0(d0) do { s16x4 l0, l1, l2, l3, h0, h1, h2, h3; constexpr int b_ = VB * SHM_V + v_rd_off(d0, 0, 0); \
        TRRD(l0, vb0, b_); TRRD(h0, vb0, b_ + 2048); TRRD(l1, vb0, b_ + 4096); TRRD(h1, vb0, b_ + 6144); TRRD(l2, vb0, b_ + 8192); TRRD(h2, vb0, b_ + 10240); TRRD(l3, vb0, b_ + 12288); TRRD(h3, vb0, b_ + 14336); \
        asm volatile("s_waitcnt lgkmcnt(0)" ::: "memory"); SBAR(); \
        o[d0] = __builtin_amdgcn_mfma_f32_32x32x16_bf16(pa0, (bf16x8){l0[0], l0[1], l0[2], l0[3], h0[0], h0[1], h0[2], h0[3]}, o[d0], 0, 0, 0);   \
        o[d0] = __builtin_amdgcn_mfma_f32_32x32x16_bf16(pa1, (bf16x8){l1[0], l1[1], l1[2], l1[3], h1[0], h1[1], h1[2], h1[3]}, o[d0], 0, 0, 0);   \
        o[d0] = __builtin_amdgcn_mfma_f32_32x32x16_bf16(pa2, (bf16x8){l2[0], l2[1], l2[2], l2[3], h2[0], h2[1], h2[2], h2[3]}, o[d0], 0, 0, 0);   \
        o[d0] = __builtin_amdgcn_mfma_f32_32x32x16_bf16(pa3, (bf16x8){l3[0], l3[1], l3[2], l3[3], h3[0], h3[1], h3[2], h3[3]}, o[d0], 0, 0, 0); } while (0)
    PV_D0(0); PV_D0(1); PV_D0(2); PV_D0(3);
#undef PV_D0
}
struct BlockRef { const bf16* Q; const bf16* K; const bf16* V; const float* KX; bf16* O; int P0; };
struct Seam { bf16x8 qr[8]; bf16x8 st_v0, st_v1, st_k0, st_k1; float st_kx; };
#define ROWP(p, k0, rr) ((p) + (size_t)((k0) + (rr)) * PITCH + sc)
#define VMW() asm volatile("s_waitcnt vmcnt(0)" ::: "memory")
#define VMWN(n) asm volatile("s_waitcnt vmcnt(%0)" :: "i"(n) : "memory")
#define SLOAD_H(Kp, Vp, KXp, k0) do { S.st_v0 = *(const bf16x8*)ROWP(Vp, k0, sr); S.st_v1 = *(const bf16x8*)ROWP(Vp, k0, 32 + sr);              \
                         S.st_k0 = *(const bf16x8*)ROWP(Kp, k0, sr); S.st_k1 = *(const bf16x8*)ROWP(Kp, k0, 32 + sr); \
                         S.st_kx = (KXp)[(k0) + (tid & 63)]; } while (0)
#define SWRITE_HK(bf) do { *(bf16x8*)(K_lds + (bf) * SHM_K + kws) = S.st_k0; *(bf16x8*)(K_lds + (bf) * SHM_K + kws + 32 * 256) = S.st_k1; \
                           if (tid < 64) *(float*)(KX_lds + (bf) * 256 + tid * 4) = S.st_kx; } while (0)
#define SWRITE_HV(bf) do { *(bf16x8*)(V_lds + (bf) * SHM_V + vst0) = S.st_v0; *(bf16x8*)(V_lds + (bf) * SHM_V + vst1) = S.st_v1; } while (0)
#define SWRITE_H(bf) do { SWRITE_HV(bf); SWRITE_HK(bf); } while (0)
__device__ __forceinline__ int prime(const BlockRef& cur, float kn2, char* lds, Seam& S, int wave_) {
    unsigned m_ = ~0u; asm volatile("" : "+s"(m_)); const int tid_ = wave_ * 64 + (int)__builtin_amdgcn_mbcnt_hi(m_, __builtin_amdgcn_mbcnt_lo(m_, 0u));
    const int tid = tid_, wid = __builtin_amdgcn_readfirstlane(tid >> 6), lane = tid & 63, r32 = lane & 31, hi = lane >> 5;
    const int sr = tid >> 4, sc = (tid & 15) * 8, kws = KSWZ(sr, sc * 2); char* K_lds = lds + 2 * SHM_V; char* KX_lds = lds + OFF_KX;
    for (int d0 = 0; d0 < 8; ++d0) S.qr[d0] = *(const bf16x8*)(cur.Q + (size_t)(wid * QBLK + r32) * PITCH + d0 * 16 + hi * 8);
    float qs = 0.f;
#pragma unroll
    for (int d0 = 0; d0 < 8; ++d0)
#pragma unroll
        for (int e = 0; e < 8; ++e) { const float v = bf2f((unsigned)(unsigned short)S.qr[d0][e]); qs += v * v; }
    qs = sum32(qs);
    qs = fmaxf(qs, xor_get<1>(qs)); qs = fmaxf(qs, xor_get<2>(qs)); qs = fmaxf(qs, xor_get<4>(qs)); qs = fmaxf(qs, xor_get<8>(qs)); qs = fmaxf(qs, xor_get<16>(qs));
    float* red = (float*)(lds + OFF_WS);
    if (lane == 0) red[wid] = qs;
    __syncthreads();
    float qn2 = red[0];
#pragma unroll
    for (int w = 1; w < 8; ++w) qn2 = fmaxf(qn2, red[w]);
    const float thr = cur.KX[cur.P0] - (2.02f * sqrtf(qn2 * kn2) + 170.f);
    const int nbefore = cur.P0 / KVBLK;
    const bool f0 = lane < nbefore && cur.KX[KVBLK * lane + KVBLK - 1] <= thr, f1 = lane + 64 < nbefore && cur.KX[KVBLK * (lane + 64) + KVBLK - 1] <= thr;
    const int j_lo = __builtin_amdgcn_readfirstlane(__popcll(__ballot(f0)) + __popcll(__ballot(f1)));
    SLOAD_H(cur.K, cur.V, cur.KX, j_lo * KVBLK); VMW(); SWRITE_HK(0);
    __syncthreads();
    return j_lo;
}
__device__ __forceinline__ void block(const BlockRef& cur, const int j_lo, char* lds, Seam& S, int wave_) {
    unsigned m_ = ~0u; asm volatile("" : "+s"(m_)); const int tid_ = wave_ * 64 + (int)__builtin_amdgcn_mbcnt_hi(m_, __builtin_amdgcn_mbcnt_lo(m_, 0u));
    const int tid = tid_, wid = __builtin_amdgcn_readfirstlane(tid >> 6), lane = tid & 63, r32 = lane & 31, hi = lane >> 5;
    const int NT = (cur.P0 + QB - 1) / KVBLK + 1 - j_lo;
    const int qlo = cur.P0 + wid * QBLK, qm = qlo + r32 - 4 * hi;
    char* V_lds = lds; char* K_lds = lds + 2 * SHM_V; char* KX_lds = lds + OFF_KX;
    float* wsp = (float*)(lds + OFF_WS) + wid * 64; float* li_l = wsp, * al_l = wsp + 32;
    float m_reg = -1e30f, l_reg = 0; f32x16 o[4] = {};
    const int sr = tid >> 4, sc = (tid & 15) * 8, vst0 = v_st(sr, sc), vst1 = v_st(32 + sr, sc), kws = KSWZ(sr, sc * 2);
    const int vb0 = (int)(uintptr_t)V_lds + v_rd_base(lane);
    const bf16* Kh = cur.K; const bf16* Vh = cur.V; const float* KXh = cur.KX;
    const unsigned W = 0x40000000u;
    const char* kxb = KX_lds + hi * 16;
#define RESC(a) do { if (__any((a) < 1.f)) { if (hi == 0) al_l[r32] = (a); asm volatile("s_waitcnt lgkmcnt(0)" ::: "memory");              \
                     for (int d_ = 0; d_ < 4; ++d_) for (int r = 0; r < 16; ++r) o[d_][r] *= al_l[crow(r, hi)]; } } while (0)
#define KBASE(t) ((j_lo + (t)) * KVBLK)
#define BIAS(P0_, P1_, kb_i) do { _Pragma("unroll") for (int rq = 0; rq < 4; ++rq) { \
        const f32x4 c0_ = *reinterpret_cast<const f32x4*>(kxb + (kb_i) * 256 + rq * 32), c1_ = *reinterpret_cast<const f32x4*>(kxb + (kb_i) * 256 + 128 + rq * 32); \
        P0_[4 * rq] += c0_[0]; P0_[4 * rq + 1] += c0_[1]; P0_[4 * rq + 2] += c0_[2]; P0_[4 * rq + 3] += c0_[3]; P1_[4 * rq] += c1_[0]; P1_[4 * rq + 1] += c1_[1]; P1_[4 * rq + 2] += c1_[2]; P1_[4 * rq + 3] += c1_[3]; SBAR(); } } while (0)
#define MASKT(P0_, P1_, t) do { const int kb_ = KBASE(t); BIAS(P0_, P1_, (t) & 1); if (kb_ + KVBLK - 1 > qlo) mask_tile(P0_, P1_, qm - kb_, W); } while (0)
    f32x16 pA0, pA1, pB0, pB1; float mnA, mnB, alA, alB; bf16x8 pa0, pa1, pa2, pa3;
    SWRITE_HV(0); SBAR();
    if (NT > 1) { SLOAD_H(Kh, Vh, KXh, KBASE(1)); }
    SBAR(); qkt<0>(pA0, pA1, K_lds, r32, hi, S.qr);
    MASKT(pA0, pA1, 0); partialSM(pA0, pA1, m_reg, mnA, alA);
    if (NT > 1) { VMW(); SWRITE_H(1); }
    __syncthreads();
#define HALF_STEP(PX0, PX1, mnX, alX, PY0, PY1, alY, t, KB, VB, SB) do {                                                      \
        SBAR(); qkt<KB>(PX0, PX1, K_lds, r32, hi, S.qr);                                             \
        finishSM(PY0, PY1, alY, l_reg, pa0, pa1, pa2, pa3); SBAR();                                                           \
        if ((t) + 1 < NT) { SLOAD_H(Kh, Vh, KXh, KBASE((t) + 1)); SBAR(); }                                               \
        pv_tile<VB>(o, vb0, pa0, pa1, pa2, pa3); MASKT(PX0, PX1, (t)); partialSM(PX0, PX1, m_reg, mnX, alX);                                        \
        __syncthreads();                                                                                                      \
        if ((t) + 1 < NT) { VMW(); SWRITE_H(SB); }                                                                          \
        RESC(alX); __syncthreads(); } while (0)
    for (int t = 1; t + 1 < NT; t += 2) {
        HALF_STEP(pB0, pB1, mnB, alB, pA0, pA1, alA, t, 1, 0, 0);
        HALF_STEP(pA0, pA1, mnA, alA, pB0, pB1, alB, t + 1, 0, 1, 1);
    }
    const bool even = (NT & 1) == 0;
    if (even) { SBAR(); qkt<1>(pB0, pB1, K_lds, r32, hi, S.qr); SBAR(); }
    finishSM(pA0, pA1, alA, l_reg, pa0, pa1, pa2, pa3); SBAR();
    pv_tile<0>(o, vb0, pa0, pa1, pa2, pa3);
    if (even) { MASKT(pB0, pB1, NT - 1); partialSM(pB0, pB1, m_reg, mnB, alB); __syncthreads(); RESC(alB);
        finishSM(pB0, pB1, alB, l_reg, pa0, pa1, pa2, pa3); SBAR(); pv_tile<1>(o, vb0, pa0, pa1, pa2, pa3); }
    SBAR();
    if (hi == 0) li_l[r32] = l_reg; asm volatile("s_waitcnt lgkmcnt(0)" ::: "memory");
    float rli[16];
#pragma unroll
    for (int r = 0; r < 16; ++r) rli[r] = __builtin_amdgcn_rcpf(li_l[crow(r, hi)]);
    bf16* Ow = cur.O + (size_t)(wid * QBLK) * PITCH;
#pragma unroll
    for (int r = 0; r < 16; ++r) { const int orow = crow(r, hi);
#pragma unroll
        for (int d0 = 0; d0 < 4; ++d0) { const float v = o[d0][r] * rli[r];
            const float vn = xor_get<1>(v);
            if ((r32 & 1) == 0) *(unsigned*)(Ow + (size_t)orow * PITCH + d0 * 32 + r32) = cvt_pk_bf16(v, vn); } }
    __syncthreads();
#undef RESC
#undef KBASE
#undef MASKT
#undef BIAS
#undef HALF_STEP
}
#undef ROWP
#undef VMW
#undef VMWN
#undef SLOAD_H
#undef SWRITE_HK
#undef SWRITE_HV
#undef SWRITE_H
}

__device__ __forceinline__ void attn_sample(const Args& a, LAS unsigned char* lds, int item, int tid) {
    int z = 0; asm volatile("" : "+s"(z));
    unsigned char* ws = a.ws + z;
    const int b = item >> 4, h = item & 15;
    asm volatile("" : "+v"(tid));
    const int wid = __builtin_amdgcn_readfirstlane(tid >> 6), lane = tid & 63, qi = lane & 15, g = lane >> 4;
    const bf16* QB_ = (const bf16*)(ws + WS_QB); const bf16* KBn = (const bf16*)(ws + WS_KB); const bf16* VBn = (const bf16*)(ws + WS_VB); bf16* OB_ = (bf16*)(ws + WS_OB);
    const float* ck = (const float*)(ws + WS_CKS) + (size_t)item * CKS_STRIDE;
    const float* Kc = a.in[I_CK + z] + ((size_t)b * PAST * NH + h) * HD; const float* Vc = a.in[I_CV + z] + ((size_t)b * PAST * NH + h) * HD;
    const size_t srow0 = (size_t)(SEQ + DEC_T * b);
    LAS unsigned char* vt = lds + wid * 9216;
    LAS float* comb = (LAS float*)(lds + 73728);
    LAS float* opart = (LAS float*)(lds);
    __syncthreads();
    bf16x8 qf[4];
#pragma unroll
    for (int ks = 0; ks < 4; ++ks) qf[ks] = *(const bf16x8*)(QB_ + (srow0 + qi) * DM + h * HD + 32 * ks + 8 * g);
    float m_run = -1e30f, l_run = 0.f; f32x4 o[8];
#pragma unroll
    for (int dt = 0; dt < 8; ++dt) o[dt] = (f32x4){0.f, 0.f, 0.f, 0.f};
    const int vkey = lane >> 4, vch = lane & 15;
    const int trq = (lane & 15) >> 2, trp = lane & 3;
    const int tr_base = (int)(uintptr_t)vt + (4 * g + trq) * 288 + trp * 8;
    const int nsteps = wid == 0 ? 9 : 8;
    for (int stp = 0; stp < nsteps; ++stp) {
        const bool newk = stp == 8;
        const int s0 = wid * 256 + stp * 32;
        f32x4 sT[2];
        u32x4 vpk[8];
        if (!newk) {
            f32x4 kr[2][4][2];
#pragma unroll
            for (int aa = 0; aa < 2; ++aa)
#pragma unroll
                for (int ks = 0; ks < 4; ++ks) { const float* kp = Kc + (size_t)(s0 + 16 * aa + qi) * DM + 32 * ks + 8 * g; kr[aa][ks][0] = __builtin_nontemporal_load((const f32x4*)kp); kr[aa][ks][1] = __builtin_nontemporal_load((const f32x4*)(kp + 4)); }
            f32x4 vr[8][2];
#pragma unroll
            for (int it = 0; it < 8; ++it) { const float* vp = Vc + (size_t)(s0 + vkey + 4 * it) * DM + 8 * vch; vr[it][0] = __builtin_nontemporal_load((const f32x4*)vp); vr[it][1] = __builtin_nontemporal_load((const f32x4*)(vp + 4)); }
            const f32x4 c0 = *(const f32x4*)(ck + s0 + 4 * g), c1 = *(const f32x4*)(ck + s0 + 16 + 4 * g);
#pragma unroll
            for (int aa = 0; aa < 2; ++aa) { f32x4 acc = aa ? c1 : c0;
#pragma unroll
                for (int ks = 0; ks < 4; ++ks) { u32x4 pk; pk.x = cvt_pk_bf16(kr[aa][ks][0][0], kr[aa][ks][0][1]); pk.y = cvt_pk_bf16(kr[aa][ks][0][2], kr[aa][ks][0][3]); pk.z = cvt_pk_bf16(kr[aa][ks][1][0], kr[aa][ks][1][1]); pk.w = cvt_pk_bf16(kr[aa][ks][1][2], kr[aa][ks][1][3]);
                    acc = __builtin_amdgcn_mfma_f32_16x16x32_bf16(__builtin_bit_cast(bf16x8, pk), qf[ks], acc, 0, 0, 0); }
                sT[aa] = acc; }
#pragma unroll
            for (int it = 0; it < 8; ++it) { vpk[it].x = cvt_pk_bf16(vr[it][0][0], vr[it][0][1]); vpk[it].y = cvt_pk_bf16(vr[it][0][2], vr[it][0][3]); vpk[it].z = cvt_pk_bf16(vr[it][1][0], vr[it][1][1]); vpk[it].w = cvt_pk_bf16(vr[it][1][2], vr[it][1][3]); }
        } else {
            const f32x4 c0 = *(const f32x4*)(ck + PAST + 4 * g);
            f32x4 acc = c0;
#pragma unroll
            for (int ks = 0; ks < 4; ++ks) { const bf16x8 kf = *(const bf16x8*)(KBn + (srow0 + qi) * DM + h * HD + 32 * ks + 8 * g);
                acc = __builtin_amdgcn_mfma_f32_16x16x32_bf16(kf, qf[ks], acc, 0, 0, 0); }
            const float NEG = -__builtin_inff();
#pragma unroll
            for (int j = 0; j < 4; ++j) if (4 * g + j > qi) acc[j] = NEG;
            sT[0] = acc; sT[1] = (f32x4){NEG, NEG, NEG, NEG};
#pragma unroll
            for (int it = 0; it < 8; ++it) { vpk[it] = (u32x4){0u, 0u, 0u, 0u};
                if (it < 4) vpk[it] = *(const u32x4*)(VBn + (srow0 + vkey + 4 * it) * DM + h * HD + 8 * vch); }
        }
        float tmax = fmaxf(fmaxf(fmaxf(sT[0][0], sT[0][1]), fmaxf(sT[0][2], sT[0][3])), fmaxf(fmaxf(sT[1][0], sT[1][1]), fmaxf(sT[1][2], sT[1][3])));
        tmax = fmaxf(tmax, xor_get<16>(tmax)); tmax = max32(tmax);
        const float mn = fmaxf(m_run, tmax); const float alpha = __builtin_amdgcn_exp2f(m_run - mn); m_run = mn;
        float p[8]; float ps = 0.f;
#pragma unroll
        for (int j = 0; j < 4; ++j) { p[j] = __builtin_amdgcn_exp2f(sT[0][j] - mn); p[4 + j] = __builtin_amdgcn_exp2f(sT[1][j] - mn); ps += p[j] + p[4 + j]; }
        ps += xor_get<16>(ps); ps = sum32(ps);
        l_run = l_run * alpha + ps;
        u32x4 ppk; ppk.x = cvt_pk_bf16(p[0], p[1]); ppk.y = cvt_pk_bf16(p[2], p[3]); ppk.z = cvt_pk_bf16(p[4], p[5]); ppk.w = cvt_pk_bf16(p[6], p[7]);
        const bf16x8 pfrag = __builtin_bit_cast(bf16x8, ppk);
#pragma unroll
        for (int it = 0; it < 8; ++it) *(LAS u32x4*)(vt + (vkey + 4 * it) * 288 + vch * 16) = vpk[it];
        asm volatile("s_waitcnt lgkmcnt(0)" ::: "memory");
#define SA_PV(dt) do { s16x4 lo, hi4; TRRD(lo, tr_base, (dt) * 32); TRRD(hi4, tr_base, (dt) * 32 + 16 * 288); \
            asm volatile("s_waitcnt lgkmcnt(0)" ::: "memory"); __builtin_amdgcn_sched_barrier(0); \
            const f32x4 od = o[dt] * alpha; \
            o[dt] = __builtin_amdgcn_mfma_f32_16x16x32_bf16((bf16x8){lo[0], lo[1], lo[2], lo[3], hi4[0], hi4[1], hi4[2], hi4[3]}, pfrag, od, 0, 0, 0); } while (0)
        SA_PV(0); SA_PV(1); SA_PV(2); SA_PV(3); SA_PV(4); SA_PV(5); SA_PV(6); SA_PV(7);
#undef SA_PV
        asm volatile("s_waitcnt lgkmcnt(0)" ::: "memory");
    }
    __syncthreads();
    if (g == 0) { comb[wid * 32 + qi] = m_run; comb[wid * 32 + 16 + qi] = l_run; }
#pragma unroll
    for (int dt = 0; dt < 8; ++dt) *(LAS f32x4*)(opart + ((size_t)(wid * 16 + qi) * 128 + 16 * dt + 4 * g)) = o[dt];
    __syncthreads();
    { const int q = tid >> 5, d4 = (tid & 31) * 4;
      float mm = -1e30f;
#pragma unroll
      for (int w = 0; w < 8; ++w) mm = fmaxf(mm, comb[w * 32 + q]);
      float lt = 0.f; f32x4 acc = (f32x4){0.f, 0.f, 0.f, 0.f};
#pragma unroll
      for (int w = 0; w < 8; ++w) { const float sc = __builtin_amdgcn_exp2f(comb[w * 32 + q] - mm); lt += comb[w * 32 + 16 + q] * sc; acc += *(const LAS f32x4*)(opart + ((size_t)(w * 16 + q) * 128 + d4)) * sc; }
      const float inv = 1.0f / lt;
      u32x2 w2; w2.x = cvt_pk_bf16(acc[0] * inv, acc[1] * inv); w2.y = cvt_pk_bf16(acc[2] * inv, acc[3] * inv);
      *(u32x2*)(OB_ + (srow0 + q) * DM + h * HD + d4) = w2; }
    __syncthreads();
}

__device__ __forceinline__ void logf_task(const Args& a, const LAS float* wfg, int rowbase, int nvalid, int lane) {
    int z = 0; asm volatile("" : "+s"(z)); asm volatile("" : "+v"(lane));
    const bf16* X = (const bf16*)(a.ws + z + WS_XB);
    float acc[64]; float ssq[4];
#pragma unroll
    for (int i = 0; i < 64; ++i) acc[i] = 0.f;
#pragma unroll
    for (int r = 0; r < 4; ++r) ssq[r] = 0.f;
    u32x4 xr[4][4];
#pragma unroll
    for (int r = 0; r < 4; ++r) { const int rr = r < nvalid ? r : 0;
#pragma unroll
        for (int i = 0; i < 4; ++i) xr[r][i] = *(const u32x4*)(X + (size_t)(rowbase + rr) * DM + 512 * i + 8 * lane); }
#pragma unroll
    for (int i = 0; i < 4; ++i)
#pragma unroll
        for (int e = 0; e < 8; ++e) { float xv[4];
#pragma unroll
            for (int r = 0; r < 4; ++r) { const unsigned w2 = e < 2 ? xr[r][i].x : (e < 4 ? xr[r][i].y : (e < 6 ? xr[r][i].z : xr[r][i].w)); xv[r] = bf2f((e & 1) ? (w2 >> 16) : (w2 & 0xffffu)); ssq[r] += xv[r] * xv[r]; }
#pragma unroll
            for (int h = 0; h < 16; ++h) { const float w = wfg[h * DM + 512 * i + 64 * e + lane];
#pragma unroll
                for (int r = 0; r < 4; ++r) acc[r * 16 + h] += xv[r] * w; }
        }
#pragma unroll
    for (int r = 0; r < 4; ++r) ssq[r] = wave_sum(ssq[r]);
#define RS_STEP(o, n) do { const bool up = (lane & (o)) != 0; _Pragma("unroll") for (int i = 0; i < (n) / 2; ++i) { const float send = up ? acc[i] : acc[i + (n) / 2]; const float keep = up ? acc[i + (n) / 2] : acc[i]; acc[i] = keep + lane_get(send, lane ^ (o)); } } while (0)
    RS_STEP(32, 64); RS_STEP(16, 32); RS_STEP(8, 16); RS_STEP(4, 8); RS_STEP(2, 4); RS_STEP(1, 2);
#undef RS_STEP
    const int r = lane >> 4, h = lane & 15;
    const float ss = r == 0 ? ssq[0] : (r == 1 ? ssq[1] : (r == 2 ? ssq[2] : ssq[3]));
    const float rs = 1.0f / sqrtf(ss * (1.0f / DM) + RMS_EPS);
    const float zz = acc[0] * rs + a.in[I_BF + z][h];
    const float lf = fminf(zz, 0.f) - log1pf(__expf(-fabsf(zz)));
    if (r < nvalid) { const int row = rowbase + r;
        ((float*)(a.ws + z + WS_LOGF))[(size_t)row * NH + h] = lf;
        if (row < SEQ) a.out[O_LP + (size_t)row * NH + h] = lf; else a.out[O_LS + (size_t)(row - SEQ) * NH + h] = lf; }
}
__device__ __forceinline__ void logf_phase(const Args& a, LAS unsigned char* lds, int wgid, int tid) {
    LAS float* wfg = (LAS float*)lds;
    int z = 0; asm volatile("" : "+s"(z)); asm volatile("" : "+v"(tid));
    const int wave = __builtin_amdgcn_readfirstlane(tid >> 6), lane = tid & 63;
    __syncthreads();
    { const float* wf = a.in[I_WF + z]; const float* kvn = a.in[I_KVN + z]; f32x4 wv[4][4]; float gk[4];
#pragma unroll
      for (int q = 0; q < 4; ++q) { const int k = tid + 512 * q; gk[q] = kvn[k];
#pragma unroll
          for (int j = 0; j < 4; ++j) wv[q][j] = *(const f32x4*)(wf + (size_t)k * NH + 4 * j); }
#pragma unroll
      for (int q = 0; q < 4; ++q) { const int pos = 512 * q + 64 * (tid & 7) + (tid >> 3);
#pragma unroll
          for (int j = 0; j < 4; ++j)
#pragma unroll
              for (int c = 0; c < 4; ++c) wfg[(4 * j + c) * DM + pos] = wv[q][j][c] * gk[q]; } }
    __syncthreads();
    const int base = 33 * wgid;
    logf_task(a, wfg, base + 4 * wave, 4, lane);
    if (wave == 0) logf_task(a, wfg, base + 32, 1, lane);
    __syncthreads();
}
__device__ __forceinline__ void cumsum_phase(const Args& a_, LAS unsigned char* lds, int wgid, int tid) {
    int z = 0; asm volatile("" : "+s"(z)); asm volatile("" : "+v"(tid));
    struct { unsigned char* ws; } a; a.ws = a_.ws + z;
    const float* LF = (const float*)(a.ws + WS_LOGF);
    if (wgid >= 0 && wgid < NH) {
        const int h = wgid, lane = tid & 63, wave = tid >> 6; LAS float* wt = (LAS float*)lds;
        float v[16]; float run = 0.f;
#pragma unroll
        for (int i = 0; i < 16; ++i) { run += LF[(size_t)(16 * tid + i) * NH + h]; v[i] = run; }
        float incl = run;
#pragma unroll
        for (int o = 1; o < 64; o <<= 1) { const float t = lane_get(incl, lane >= o ? lane - o : lane); if (lane >= o) incl += t; }
        __syncthreads();
        if (lane == 63) wt[wave] = incl;
        __syncthreads();
        float pre = incl - run;
        for (int w = 0; w < wave; ++w) pre += wt[w];
        float* KX = (float*)(a.ws + WS_KX) + (size_t)h * SEQ + 16 * tid;
#pragma unroll
        for (int i = 0; i < 16; i += 4) *(f32x4*)(KX + i) = (f32x4){-(pre + v[i]) * LOG2E, -(pre + v[i + 1]) * LOG2E, -(pre + v[i + 2]) * LOG2E, -(pre + v[i + 3]) * LOG2E};
        __syncthreads();
    } else if (wgid == NH) {
        if (tid < 256) { const int b = tid >> 4, h = tid & 15; float c = ((const float*)(a.ws + WS_CEND))[tid]; float* dst = (float*)(a.ws + WS_CKS) + (size_t)tid * CKS_STRIDE + PAST;
#pragma unroll 1
            for (int i = 0; i < DEC_T; ++i) { c += LF[(size_t)(SEQ + DEC_T * b + i) * NH + h]; dst[i] = -c * LOG2E; } }
    }
}

__device__ __forceinline__ void kn_phase(const Args& a_, int wgid, int tid) {
    int z = 0; asm volatile("" : "+s"(z)); asm volatile("" : "+v"(tid));
    const bf16* Kb = (const bf16*)(a_.ws + z + WS_KB); unsigned* kn2 = (unsigned*)(a_.ws + z + WS_CTL) + CW_KN2;
    const int h = wgid & 15, key = 512 * (wgid >> 4) + tid;
    const u32x4* p = (const u32x4*)(Kb + (size_t)key * DM + h * HD); float ks = 0.f;
#pragma unroll
    for (int i = 0; i < 16; ++i) { const u32x4 w = p[i]; const unsigned ww[4] = {w.x, w.y, w.z, w.w};
#pragma unroll
        for (int j = 0; j < 4; ++j) { const float lo = bf2f(ww[j] & 0xffffu), hi = bf2f(ww[j] >> 16); ks += lo * lo + hi * hi; } }
    ks = fmaxf(ks, xor_get<1>(ks)); ks = fmaxf(ks, xor_get<2>(ks)); ks = fmaxf(ks, xor_get<4>(ks)); ks = fmaxf(ks, xor_get<8>(ks)); ks = fmaxf(ks, xor_get<16>(ks)); ks = max32(ks);
    if ((tid & 63) == 0) atomicMax(kn2 + h, __builtin_bit_cast(unsigned, ks));
}

__global__ void __launch_bounds__(NWAVES * 64, 2) yoco_fwd(Args args) {
    extern __shared__ __attribute__((aligned(16))) unsigned char lds_raw[];
    LAS unsigned char* lds = (LAS unsigned char*)lds_raw;
    volatile LAS unsigned* MISC = (volatile LAS unsigned*)(lds + MISC_OFF);
    LAS float* rtab = (LAS float*)(lds + RTAB_OFF);
    const int wave = __builtin_amdgcn_readfirstlane((int)threadIdx.x >> 6);
    const int G = gridDim.x, bx = blockIdx.x;
    unsigned char* ws = args.ws;
    unsigned* ctl = (unsigned*)(ws + WS_CTL);
    for (int u = threadIdx.x; u < (LDS_BYTES - MISC_OFF) / 4; u += NWAVES * 64) ((LAS unsigned*)(lds + MISC_OFF))[u] = 0u;
    __syncthreads();
#if MK_PER_PHASE
#define GRID_BAR() do { } while (0)
#else
    XcdBarrier bar = xcd_barrier_post(ctl + CW_BAR, MISC + 8);
#define GRID_BAR() xcd_barrier(bar)
#endif
    int ph = 0;
#define PHASE_ON() (ph >= args.ph_lo && ph < args.ph_hi)
#define PHASE_END() do { if (ph + 1 < args.ph_hi && ph >= args.ph_lo) GRID_BAR(); ++ph; } while (0)


#define LAUNDER() unsigned m_ = ~0u; int Gp = G, bxp = bx, zz_ = 0; asm volatile("" : "+s"(m_), "+s"(Gp), "+s"(bxp), "+s"(zz_)); const int lanep = (int)__builtin_amdgcn_mbcnt_hi(m_, __builtin_amdgcn_mbcnt_lo(m_, 0u)), tidp = wave * 64 + lanep; unsigned char* wz = ws + zz_; bf16* XBz = (bf16*)(wz + WS_XB); float* Pz = (float*)(wz + WS_P); bf16* ACTz = (bf16*)(wz + WS_ACT); (void)XBz; (void)Pz; (void)ACTz; (void)lanep; (void)tidp
    if (PHASE_ON() && !(DIS & 1)) for (int rp = 0; rp < REPS(1); ++rp) { if (rp) GRID_BAR(); LAUNDER(); const int vcup = (Gp % 8 == 0) ? (bxp % 8) * (Gp / 8) + bxp / 8 : bxp; prologue(args, lds, vcup, Gp, wave, lanep); }
    PHASE_END();

    for (int hl = 0; hl < 8; ++hl) {
        const int l = hl >> 1, f = hl & 1;
        if (hl == 4) {
            if (PHASE_ON() && !(DIS & 2)) for (int rp = 0; rp < REPS(2); ++rp) { if (rp) GRID_BAR(); LAUNDER(); logf_phase(args, lds, bxp, tidp); }
            PHASE_END();
        }
        if (PHASE_ON()) {
            if (hl == 4 && !(DIS & 4)) { LAUNDER(); cumsum_phase(args, lds, bxp - 188, tidp); }
            if (!(DIS & 8)) for (int rp = 0; rp < REPS(8); ++rp) { if (rp) GRID_BAR(); LAUNDER(); pg8::Gemm g{XBz, (const bf16*)(wz + WS_WGU + (size_t)hl * SZ_WGU), M, 2 * FF, DM}; pg8::HybridOrder S; S.init(M, 2 * FF, DM, Gp, bxp, false);
              build_rtab(rtab, Pz, S, tidp);
              pg8::EpiSwiGLU E{ACTz, rtab};
              pg8::gemm_phase<pg8::EpiSwiGLU>(lds, g, S, E, wz + WS_SLAB, tidp); }
            if (hl == 4 && !(DIS & 16)) for (int rp = 0; rp < REPS(16); ++rp) {
                if (rp) GRID_BAR(); LAUNDER(); pg8::Gemm g{XBz, (const bf16*)(wz + WS_WKV), M, 2 * DM, DM}; pg8::HybridOrder S; S.init(M, 2 * DM, DM, Gp, (bxp + 84) % Gp, false);
                build_rtab(rtab, Pz, S, tidp);
                pg8::EpiKV E{args.out + zz_, (bf16*)(wz + WS_KB), (bf16*)(wz + WS_VB), rtab};
                pg8::gemm_phase<pg8::EpiKV>(lds, g, S, E, wz + WS_SLAB, tidp);
            }
        }
        PHASE_END();
        if (PHASE_ON() && !(DIS & 32)) for (int rp = 0; rp < REPS(32); ++rp) {
            if (rp) GRID_BAR(); LAUNDER();
            if (hl == 4 && rp == 0) kn_phase(args, bxp, tidp); pg8::Gemm g{ACTz, (const bf16*)(wz + WS_WD + (size_t)hl * SZ_WD), SEQ, DM, FF}; pg8::HybridOrder S; S.init(SEQ, DM, FF, Gp, bxp, false);
            pg8::EpiResid E{XBz, Pz, rp + 1 == REPS(32) ? 0.5f : 0.0f}; pg8::SEpiResid SE{XBz, Pz, E.alpha, (LAS float*)(lds + MISC_OFF + 1024)};
            pg8::gemm_phase<pg8::EpiResid, true, true, pg8::SEpiResid>(lds, g, S, E, wz + WS_SLAB, tidp, SE);
        }
        PHASE_END();
        if (f == 0) {
            if (l < 2) {
                if (PHASE_ON() && !(DIS & 64)) for (int rp = 0; rp < REPS(64); ++rp) {
                    if (rp) GRID_BAR(); LAUNDER(); pg8::Gemm g{XBz, (const bf16*)(wz + WS_WIN + (size_t)l * SZ_WIN), SEQ, 2 * DG, DM}; pg8::HybridOrder S; S.init(SEQ, 2 * DG, DM, Gp, bxp, false);
                    build_rtab(rtab, Pz, S, tidp); build_srt((LAS float*)(lds + MISC_OFF + 2048), Pz, S, tidp);
                    pg8::EpiGelu E{(bf16*)(wz + WS_U), (bf16*)(wz + WS_V), (f32x2*)(wz + WS_S1), rtab}; pg8::SEpiGelu SE{(bf16*)(wz + WS_U), (bf16*)(wz + WS_V), (f32x2*)(wz + WS_S1), (const LAS float*)(lds + MISC_OFF + 2048), (LAS float*)(lds + MISC_OFF + 1024)};
                    pg8::gemm_phase<pg8::EpiGelu, true, true, pg8::SEpiGelu>(lds, g, S, E, wz + WS_SLAB, tidp, SE);
                }
                PHASE_END();
                if (PHASE_ON() && !(DIS & 128)) for (int rp = 0; rp < REPS(128); ++rp) {
                    if (rp) GRID_BAR(); LAUNDER(); for (int u = bxp; u < 320; u += Gp) {
                        if (u < 256) mix_unit(args, lds, l, 128 * (u >> 2), 128, u & 3, nullptr, tidp);
                        else { const int b = (u - 256) >> 2; mix_unit(args, lds, l, SEQ + DEC_T * b, DEC_T, (u - 256) & 3, args.out + zz_ + O_GV + ((size_t)l * NSAMP + DEC_T * b) * DG, tidp); }
                    }
                }
                PHASE_END();
                if (PHASE_ON() && !(DIS & 256)) for (int rp = 0; rp < REPS(256); ++rp) {
                    if (rp) GRID_BAR(); LAUNDER(); pg8::Gemm g{(const bf16*)(wz + WS_G), (const bf16*)(wz + WS_WOUT + (size_t)l * SZ_WOUT), SEQ, DM, DG}; pg8::HybridOrder S; S.init(SEQ, DM, DG, Gp, bxp, false);
                    pg8::EpiResid E{XBz, Pz, rp + 1 == REPS(256) ? 1.0f : 0.0f}; pg8::SEpiResid SE{XBz, Pz, E.alpha, (LAS float*)(lds + MISC_OFF + 1024)};
                    pg8::gemm_phase<pg8::EpiResid, true, true, pg8::SEpiResid>(lds, g, S, E, wz + WS_SLAB, tidp, SE);
                }
                PHASE_END();
            } else {
                if (PHASE_ON() && !(DIS & 512)) for (int rp = 0; rp < REPS(512); ++rp) {
                    if (rp) GRID_BAR(); LAUNDER(); pg8::Gemm g{XBz, (const bf16*)(wz + WS_WQ + (size_t)(l - 2) * SZ_WQ), SEQ, DM, DM}; pg8::HybridOrder S; S.init(SEQ, DM, DM, Gp, bxp, false);
                    build_rtab(rtab, Pz, S, tidp); build_srt((LAS float*)(lds + MISC_OFF + 2048), Pz, S, tidp);
                    pg8::EpiQ E{(bf16*)(wz + WS_QB), rtab, Pz}; pg8::SEpiQ SE{(bf16*)(wz + WS_QB), (const LAS float*)(lds + MISC_OFF + 2048)};
                    pg8::gemm_phase<pg8::EpiQ, true, true, pg8::SEpiQ>(lds, g, S, E, wz + WS_SLAB, tidp, SE);
                }
                PHASE_END();
                if (PHASE_ON()) {
                    LAUNDER();
                    const bf16* Qb = (const bf16*)(wz + WS_QB); const bf16* Kb = (const bf16*)(wz + WS_KB); const bf16* Vb = (const bf16*)(wz + WS_VB); const float* KX = (const float*)(wz + WS_KX); bf16* Ob = (bf16*)(wz + WS_OB);
                    __syncthreads();
                    for (int rp = 0; rp < REPS(1024); ++rp) {
                        unsigned* tkc = (unsigned*)(wz + WS_CTL) + CW_TK + 64 * ((l - 2) * 2 + rp); LAS unsigned* tkw = (LAS unsigned*)(lds + 75776);
                        const unsigned* kn2p = (const unsigned*)(wz + WS_CTL) + CW_KN2;
                        for (;;) {
                            if (tidp == 0) *tkw = __hip_atomic_fetch_add(tkc, 1u, __ATOMIC_RELAXED, __HIP_MEMORY_SCOPE_AGENT);
                            __syncthreads();
                            const int it = (int)__builtin_amdgcn_readfirstlane(*tkw);
                            if (it >= 768) break;
                            if (it < 512 && (it & 1)) { attn_sample(args, lds, it >> 1, tidp); continue; }
                            const int ip = it < 512 ? (it >> 1) : it - 256, h = ip & 15, qb = 31 - (ip >> 4);
                            fa::BlockRef b0;
                            b0.Q = Qb + (size_t)(qb * 256) * DM + h * HD; b0.O = Ob + (size_t)(qb * 256) * DM + h * HD; b0.K = Kb + h * HD; b0.V = Vb + h * HD; b0.KX = KX + (size_t)h * SEQ; b0.P0 = qb * 256;
                            fa::Seam S;
                            const int j_lo = fa::prime(b0, __builtin_bit_cast(float, kn2p[h]), (char*)lds_raw, S, wave);
                            fa::block(b0, j_lo, (char*)lds_raw, S, wave);
                        }
                        VM_WAIT(); __syncthreads();
                    }
                }
                PHASE_END();
                if (PHASE_ON() && !(DIS & 4096)) for (int rp = 0; rp < REPS(4096); ++rp) {
                    if (rp) GRID_BAR(); LAUNDER(); pg8::Gemm g{(const bf16*)(wz + WS_OB), (const bf16*)(wz + WS_WO + (size_t)(l - 2) * SZ_WQ), SEQ, DM, DM}; pg8::HybridOrder S; S.init(SEQ, DM, DM, Gp, bxp, false);
                    pg8::EpiResid E{XBz, Pz, rp + 1 == REPS(4096) ? 1.0f : 0.0f}; pg8::SEpiResid SE{XBz, Pz, E.alpha, (LAS float*)(lds + MISC_OFF + 1024)};
                    pg8::gemm_phase<pg8::EpiResid, true, true, pg8::SEpiResid>(lds, g, S, E, wz + WS_SLAB, tidp, SE);
                }
                PHASE_END();
            }
        }
    }
    if (PHASE_ON() && !(DIS & 8192)) for (int rp = 0; rp < REPS(8192); ++rp) {
        if (rp) GRID_BAR(); LAUNDER(); const int lane = lanep; const int vcup = (Gp % 8 == 0) ? (bxp % 8) * (Gp / 8) + bxp / 8 : bxp; const bf16* X = XBz; float* P = Pz;
        const float* gn = args.in[I_FN + zz_]; const int gw = vcup * NWAVES + wave, NGW = Gp * NWAVES;
        f32x4 gg[8];
#pragma unroll
        for (int j = 0; j < 8; ++j) gg[j] = *(const f32x4*)(gn + 256 * j + 4 * lane);
        u32x2 xw[8]; float sp = 0.f; int m = gw;
        if (m < M) { sp = lane < 32 ? P[(size_t)m * 32 + lane] : 0.f;
#pragma unroll
            for (int j = 0; j < 8; ++j) xw[j] = *(const u32x2*)(X + (size_t)m * DM + 256 * j + 4 * lane); }
        while (m < M) {
            const int mn = m + NGW; u32x2 xn[8]; float sn = 0.f;
#pragma unroll
            for (int j = 0; j < 8; ++j) xn[j] = xw[j];
            if (mn < M) { sn = lane < 32 ? P[(size_t)mn * 32 + lane] : 0.f;
#pragma unroll
                for (int j = 0; j < 8; ++j) xn[j] = *(const u32x2*)(X + (size_t)mn * DM + 256 * j + 4 * lane); }
            const float s = wave_sum(sp);
            const float r = 1.0f / sqrtf(s * (1.0f / DM) + RMS_EPS);
            float* dst = m < SEQ ? args.out + O_YP + (size_t)m * DM : args.out + O_YS + (size_t)(m - SEQ) * DM;
#pragma unroll
            for (int j = 0; j < 8; ++j) { const u32x2 xr = xw[j]; const f32x4 v = (f32x4){bf2f(xr.x & 0xffffu), bf2f(xr.x >> 16), bf2f(xr.y & 0xffffu), bf2f(xr.y >> 16)};
                *(f32x4*)(dst + 256 * j + 4 * lane) = v * r * gg[j]; }
#pragma unroll
            for (int j = 0; j < 8; ++j) xw[j] = xn[j];
            sp = sn; m = mn;
        }
    }
    PHASE_END();
}
constexpr int N_PHASES = 1 + 1 + 8 * 2 + 4 * 3 + 1;

extern "C" void kernel_launch(void* const* d_in, const int* in_sizes, int n_in, void* d_out, int out_size, void* d_ws, size_t ws_size, hipStream_t stream) {
    static int grid = 0;
    if (grid == 0) {
        if (n_in != 28 || (size_t)out_size != O_END || ws_size < WS_END) { fprintf(stderr, "kernel_launch: unexpected shapes (n_in %d, out %d, ws %zu; need 28, %zu, >= %zu)\n", n_in, out_size, ws_size, (size_t)O_END, (size_t)WS_END); grid = -1; return; }
        int dev = 0, cus = 0, per_cu = 0;
        if (hipGetDevice(&dev) != hipSuccess || hipDeviceGetAttribute(&cus, hipDeviceAttributeMultiprocessorCount, dev) != hipSuccess) { grid = -1; return; }
        if (hipFuncSetAttribute((const void*)yoco_fwd, hipFuncAttributeMaxDynamicSharedMemorySize, LDS_BYTES) != hipSuccess) { fprintf(stderr, "kernel_launch: hipFuncSetAttribute failed\n"); grid = -1; return; }
        if (hipOccupancyMaxActiveBlocksPerMultiprocessor(&per_cu, (const void*)yoco_fwd, NWAVES * 64, LDS_BYTES) != hipSuccess || per_cu < 1) fprintf(stderr, "kernel_launch: occupancy query says %d\n", per_cu);
        (void)hipGetLastError();
        grid = cus;
        if (cus < 256) { fprintf(stderr, "kernel_launch: needs 256 co-resident workgroups, device has %d CUs\n", cus); grid = -1; return; }
        grid = 256;
    }
    if (grid < 0) return;
    (void)hipMemsetAsync((char*)d_ws + WS_CTL, 0, CTL_ZERO_BYTES, stream);
    Args a{};
    for (int i = 0; i < 28; ++i) a.in[i] = (const float*)d_in[i];
    a.out = (float*)d_out; a.ws = (unsigned char*)d_ws;
#if MK_PER_PHASE
    for (int p = 0; p < N_PHASES; ++p) { a.ph_lo = p; a.ph_hi = p + 1; hipLaunchKernelGGL(yoco_fwd, dim3(grid), dim3(NWAVES * 64), LDS_BYTES, stream, a); }
#else
    a.ph_lo = 0; a.ph_hi = N_PHASES;
    hipLaunchKernelGGL(yoco_fwd, dim3(grid), dim3(NWAVES * 64), LDS_BYTES, stream, a);
#endif
    const hipError_t le = hipPeekAtLastError();
    if (le != hipSuccess) fprintf(stderr, "kernel_launch: launch failed: %s\n", hipGetErrorName(le));
}
```
